# Optimizing an MI355X kernel written in HIP

```python
import math
import jax, jax.numpy as jnp
from jax import lax
import numpy as np

D_MODEL = 2048
BATCH = 8
SEQ = 4096
DEPTH = 2
DEC_BATCH = 32
DEC_SEQ = 32
PAST_LEN = 1024

CHUNK = 64
H_A = 8
DK_A = 64
DV_A = 2 * DK_A
H_B = 8
D_B = 128
BAND_PREV_CHUNKS = 8
BAND_REACH = BAND_PREV_CHUNKS * CHUNK
BAND_LEN = BAND_REACH + CHUNK
REL_CLIP = 128
T5_BUCKETS = 32
T5_MAX_DIST = 128
D_FF = -(-8 * D_MODEL // (3 * 256)) * 256
ALPHA = (2 * DEPTH) ** 0.25
BETA = (8 * DEPTH) ** -0.25
QBLK = 128
NEG = -1e30
LN_EPS = 1e-5
QA_W = H_A * 2 * DK_A
VA_W = H_A * DV_A
B_W = H_B * D_B
IN_WIDTHS = (QA_W, QA_W, VA_W, B_W, B_W, B_W, D_MODEL, D_MODEL)
IN_W = sum(IN_WIDTHS)
IN_SPLITS = tuple(int(v) for v in np.cumsum(IN_WIDTHS)[:-1])

kernel_name = "streaming_hybrid_diffattn_chunkband"


def layer_norm(x, g=None, b=None):
    xf = x.astype(jnp.float32)
    xc = xf - jnp.mean(xf, -1, keepdims=True)
    y = xc * lax.rsqrt(jnp.mean(xc * xc, -1, keepdims=True) + LN_EPS)
    if g is not None:
        y = y * g.astype(jnp.float32) + b.astype(jnp.float32)
    return y.astype(x.dtype)


def head_rms_norm(x, g):
    xf = x.astype(jnp.float32)
    y = xf * lax.rsqrt(jnp.mean(xf * xf, -1, keepdims=True) + LN_EPS) * g.astype(jnp.float32)
    return y.astype(x.dtype)


def t5_bucket(rel):
    nb = T5_BUCKETS // 2
    max_exact = nb // 2
    bucket = (rel > 0).astype(jnp.int32) * nb
    n = jnp.abs(rel)
    nf = jnp.maximum(n, 1).astype(jnp.float32)
    large = max_exact + (jnp.log(nf / max_exact) / math.log(T5_MAX_DIST / max_exact)
                         * (nb - max_exact)).astype(jnp.int32)
    large = jnp.minimum(large, nb - 1)
    return bucket + jnp.where(n < max_exact, n, large)


def diff_attention(q, k, v, q_pos, k_pos, t5_bias, lam, subln_g, lam_init):
    s = jnp.einsum("bqhtd,bkhtd->bthqk", q, k).astype(jnp.float32) * (DK_A ** -0.5)
    rel = k_pos[None, :] - q_pos[:, None]
    bias = jnp.moveaxis(t5_bias[t5_bucket(rel)], -1, 0).astype(jnp.float32)
    visible = (k_pos[None, :] // CHUNK) <= (q_pos[:, None] // CHUNK)
    p = jax.nn.softmax(jnp.where(visible, s + bias, NEG), axis=-1)
    a = (p[:, 0] - lam * p[:, 1]).astype(v.dtype)
    o = jnp.einsum("bhqk,bkhd->bqhd", a, v)
    o = head_rms_norm(o, subln_g) * (1.0 - lam_init)
    return o.reshape(o.shape[0], o.shape[1], H_A * DV_A)


def band_attention(q, k, v, q_pos, k_pos, rel_bias):
    s = jnp.einsum("bqhd,bkhd->bhqk", q, k).astype(jnp.float32) * (D_B ** -0.5)
    rel = jnp.clip(k_pos[None, :] - q_pos[:, None], -REL_CLIP, REL_CLIP) + REL_CLIP
    bias = jnp.moveaxis(rel_bias[rel], -1, 0).astype(jnp.float32)
    dchunk = q_pos[:, None] // CHUNK - k_pos[None, :] // CHUNK
    visible = (dchunk >= 0) & (dchunk <= BAND_PREV_CHUNKS) & (k_pos[None, :] >= 0)
    p = jax.nn.softmax(jnp.where(visible, s + bias, NEG), axis=-1).astype(v.dtype)
    o = jnp.einsum("bhqk,bkhd->bqhd", p, v)
    return o.reshape(o.shape[0], o.shape[1], H_B * D_B)


def diff_attention_prompt(q, k, v, t5_bias, lam, subln_g, lam_init):
    b, s = q.shape[:2]
    nblk = s // QBLK
    pos = jnp.arange(s)
    qb = jnp.moveaxis(q.reshape(b, nblk, QBLK, H_A, 2, DK_A), 1, 0)

    def one_block(args):
        q_blk, i = args
        return diff_attention(q_blk, k, v, i * QBLK + jnp.arange(QBLK), pos,
                              t5_bias, lam, subln_g, lam_init)

    o = lax.map(one_block, (qb, jnp.arange(nblk)))
    return jnp.moveaxis(o, 0, 1).reshape(b, s, H_A * DV_A)


def band_attention_prompt(q, k, v, rel_bias):
    b, s = q.shape[:2]
    nc = s // CHUNK
    pad = ((0, 0), (BAND_REACH, 0), (0, 0), (0, 0))
    k_pad = jnp.pad(k, pad)
    v_pad = jnp.pad(v, pad)
    band_off = jnp.arange(BAND_LEN) - BAND_REACH

    def one_chunk(n):
        start = n * CHUNK
        q_n = lax.dynamic_slice_in_dim(q, start, CHUNK, axis=1)
        k_n = lax.dynamic_slice_in_dim(k_pad, start, BAND_LEN, axis=1)
        v_n = lax.dynamic_slice_in_dim(v_pad, start, BAND_LEN, axis=1)
        return band_attention(q_n, k_n, v_n, start + jnp.arange(CHUNK), start + band_off, rel_bias)

    o = lax.map(one_chunk, jnp.arange(nc))
    return jnp.moveaxis(o, 0, 1).reshape(b, s, H_B * D_B)


def block_forward(x, c, attend, w_mod, b_mod, w_in, w_oa, w_ob, w_out, ln1_g, ln1_b,
                  w1, w3, w2, ln2_g, ln2_b):
    b, t, _ = x.shape
    mod = jax.nn.silu(c) @ w_mod + b_mod
    sh_m, sc_m, g_m, sh_f, sc_f, g_f = jnp.split(mod[:, None, :], 6, axis=-1)
    h = layer_norm(x) * (1 + sc_m) + sh_m
    qa, ka, va, qb, kb, vb, ga, gb = jnp.split(h @ w_in, IN_SPLITS, axis=-1)
    qa = qa.reshape(b, t, H_A, 2, DK_A)
    ka = ka.reshape(b, t, H_A, 2, DK_A)
    va = va.reshape(b, t, H_A, DV_A)
    qb = qb.reshape(b, t, H_B, D_B)
    kb = kb.reshape(b, t, H_B, D_B)
    vb = vb.reshape(b, t, H_B, D_B)
    oa, ob = attend(qa, ka, va, qb, kb, vb)
    merged = jax.nn.sigmoid(ga) * (oa @ w_oa) + jax.nn.sigmoid(gb) * (ob @ w_ob)
    x = layer_norm(ALPHA * x + g_m * (merged @ w_out), ln1_g, ln1_b)
    h = layer_norm(x) * (1 + sc_f) + sh_f
    f = (jax.nn.silu(h @ w1) * (h @ w3)) @ w2
    x = layer_norm(ALPHA * x + g_f * f, ln2_g, ln2_b)
    return x, ka, va, kb, vb


def setup_inputs(seed: int = 0) -> dict:
    key = jax.random.key(seed)
    ks = jax.random.split(key, 32)

    def nrm(k, shape, s):
        return jax.random.normal(k, shape, jnp.float32) * s

    band_past = min(BAND_REACH, PAST_LEN)
    D = D_MODEL
    return {
        "x_prompt": nrm(ks[0], (BATCH, SEQ, D), 1.0),
        "x_sample": nrm(ks[1], (DEC_BATCH, DEC_SEQ, D), 1.0),
        "cache_a_k": nrm(ks[2], (DEPTH, DEC_BATCH, PAST_LEN, H_A, 2, DK_A), 1.0),
        "cache_a_v": nrm(ks[3], (DEPTH, DEC_BATCH, PAST_LEN, H_A, DV_A), 1.0),
        "cache_b_k": nrm(ks[4], (DEPTH, DEC_BATCH, band_past, H_B, D_B), 1.0),
        "cache_b_v": nrm(ks[5], (DEPTH, DEC_BATCH, band_past, H_B, D_B), 1.0),
        "c_prompt": nrm(ks[6], (BATCH, D), 1.0),
        "c_sample": nrm(ks[7], (DEC_BATCH, D), 1.0),
        "w_mod": nrm(ks[8], (DEPTH, D, 6 * D), 0.5 * D ** -0.5),
        "b_mod": nrm(ks[9], (DEPTH, 6 * D), 0.02),
        "w_in": nrm(ks[10], (DEPTH, D, IN_W), D ** -0.5),
        "lambda_q1": nrm(ks[11], (DEPTH, DK_A), 0.1),
        "lambda_k1": nrm(ks[12], (DEPTH, DK_A), 0.1),
        "lambda_q2": nrm(ks[13], (DEPTH, DK_A), 0.1),
        "lambda_k2": nrm(ks[14], (DEPTH, DK_A), 0.1),
        "subln_g": 1.0 + nrm(ks[15], (DEPTH, DV_A), 0.02),
        "t5_bias": nrm(ks[16], (T5_BUCKETS, H_A), 0.5),
        "rel_bias": nrm(ks[17], (DEPTH, 2 * REL_CLIP + 1, H_B), 0.5),
        "w_oa": nrm(ks[18], (DEPTH, VA_W, D), BETA * VA_W ** -0.5),
        "w_ob": nrm(ks[19], (DEPTH, B_W, D), BETA * B_W ** -0.5),
        "w_out": nrm(ks[20], (DEPTH, D, D), BETA * D ** -0.5),
        "ln1_g": 1.0 + nrm(ks[21], (DEPTH, D), 0.02),
        "ln1_b": nrm(ks[22], (DEPTH, D), 0.02),
        "w1": nrm(ks[23], (DEPTH, D, D_FF), D ** -0.5),
        "w3": nrm(ks[24], (DEPTH, D, D_FF), D ** -0.5),
        "w2": nrm(ks[25], (DEPTH, D_FF, D), BETA * D_FF ** -0.5),
        "ln2_g": 1.0 + nrm(ks[26], (DEPTH, D), 0.02),
        "ln2_b": nrm(ks[27], (DEPTH, D), 0.02),
    }


def reference(x_prompt, x_sample, cache_a_k, cache_a_v, cache_b_k, cache_b_v, c_prompt, c_sample,
              w_mod, b_mod, w_in, lambda_q1, lambda_k1, lambda_q2, lambda_k2, subln_g, t5_bias,
              rel_bias, w_oa, w_ob, w_out, ln1_g, ln1_b, w1, w3, w2, ln2_g, ln2_b):
    past = cache_a_k.shape[2]
    band_past = cache_b_k.shape[2]
    t_new = x_sample.shape[1]
    prompt_band = min(BAND_REACH, x_prompt.shape[1])
    q_pos_s = past + jnp.arange(t_new)
    ka_pos_s = jnp.arange(past + t_new)
    kb_pos_s = past - band_past + jnp.arange(band_past + t_new)

    xp, xs = x_prompt, x_sample
    akp, avp, bkp, bvp, aks, avs, bks, bvs = [], [], [], [], [], [], [], []
    for l in range(DEPTH):
        lam_init = 0.8 - 0.6 * math.exp(-0.3 * l)
        f32 = jnp.float32
        lam = (jnp.exp(jnp.sum(lambda_q1[l].astype(f32) * lambda_k1[l].astype(f32)))
               - jnp.exp(jnp.sum(lambda_q2[l].astype(f32) * lambda_k2[l].astype(f32))) + lam_init)
        layer_w = (w_mod[l], b_mod[l], w_in[l], w_oa[l], w_ob[l], w_out[l], ln1_g[l], ln1_b[l],
                   w1[l], w3[l], w2[l], ln2_g[l], ln2_b[l])

        def attend_prompt(qa, ka, va, qb, kb, vb):
            oa = diff_attention_prompt(qa, ka, va, t5_bias, lam, subln_g[l], lam_init)
            ob = band_attention_prompt(qb, kb, vb, rel_bias[l])
            return oa, ob

        def attend_sample(qa, ka, va, qb, kb, vb):
            ka_all = jnp.concatenate([cache_a_k[l].astype(ka.dtype), ka], axis=1)
            va_all = jnp.concatenate([cache_a_v[l].astype(va.dtype), va], axis=1)
            oa = diff_attention(qa, ka_all, va_all, q_pos_s, ka_pos_s, t5_bias, lam, subln_g[l], lam_init)
            kb_all = jnp.concatenate([cache_b_k[l].astype(kb.dtype), kb], axis=1)
            vb_all = jnp.concatenate([cache_b_v[l].astype(vb.dtype), vb], axis=1)
            ob = band_attention(qb, kb_all, vb_all, q_pos_s, kb_pos_s, rel_bias[l])
            return oa, ob

        xp, ka, va, kb, vb = block_forward(xp, c_prompt, attend_prompt, *layer_w)
        akp.append(ka)
        avp.append(va)
        bkp.append(kb[:, kb.shape[1] - prompt_band:])
        bvp.append(vb[:, vb.shape[1] - prompt_band:])
        xs, ka, va, kb, vb = block_forward(xs, c_sample, attend_sample, *layer_w)
        aks.append(ka)
        avs.append(va)
        bks.append(kb)
        bvs.append(vb)

    return (xp, xs, jnp.stack(akp), jnp.stack(avp), jnp.stack(bkp), jnp.stack(bvp),
            jnp.stack(aks), jnp.stack(avs), jnp.stack(bks), jnp.stack(bvs))
```

```cpp
#include <hip/hip_runtime.h>
#include <hip/hip_bf16.h>
#include <cstdio>
#include <cstdint>
#include <cmath>

constexpr int D = 2048, NBP = 8, SEQ = 4096, NBS = 32, TS = 32, PAST = 1024, BPAST = 512, DEPTH = 2;
constexpr int MP = NBP * SEQ, MS = NBS * TS, M = MP + MS;
constexpr int NSEQ = NBP + NBS;
constexpr int INW = 10240, FF = 5632, FF2 = 2 * FF, MODW = 6 * D;
constexpr int C_QA = 0, C_KA = 1024, C_VA = 2048, C_QB = 3072, C_KB = 4096, C_VB = 5120, C_GA = 6144, C_GB = 8192;
constexpr float LN_EPS = 1e-5f;
constexpr float ALPHA = 1.4142135623730951f;
constexpr float LOG2E = 1.4426950408889634f;
constexpr float SCALE_A = 0.18033688011112042f;
constexpr float SCALE_B = 0.12751743082459868f;
constexpr size_t O_YP = 0, O_YS = 67108864, O_AKP = 69206016, O_AVP = 136314880, O_BKP = 203423744, O_BVP = 211812352,
                 O_AKS = 220200960, O_AVS = 222298112, O_BKS = 224395264, O_BVS = 226492416, O_TOTAL = 228589568;
enum { I_XP = 0, I_XS, I_CAK, I_CAV, I_CBK, I_CBV, I_CP, I_CS, I_WMOD, I_BMOD, I_WIN, I_LQ1, I_LK1, I_LQ2, I_LK2, I_SUBLN, I_T5, I_REL, I_WOA, I_WOB, I_WOUT,
       I_LN1G, I_LN1B, I_W1, I_W3, I_W2, I_LN2G, I_LN2B, N_IN };

constexpr size_t MiB = 1u << 20;
constexpr size_t WS_CTL = 0, CTL_ZERO_BYTES = 1 * MiB;
constexpr size_t WS_MISC = 1 * MiB;
constexpr size_t WS_MOD = 2 * MiB;
constexpr size_t WS_W = 8 * MiB, WS_WL = 122 * MiB;
constexpr size_t WO_WIN = 0, WO_WOA = 40 * MiB, WO_WOB = 44 * MiB, WO_WOUT = 48 * MiB, WO_W13 = 56 * MiB, WO_W2 = 100 * MiB;
constexpr size_t WS_XB = 256 * MiB;
constexpr size_t WS_OA = WS_XB, WS_OB = WS_XB + 66 * MiB;
constexpr size_t WS_H = 520 * MiB;
constexpr size_t WS_QKVG = 652 * MiB;
constexpr size_t WS_END = 1312 * MiB;
static_assert(WS_W + 2 * WS_WL <= WS_XB && WS_XB + (size_t)M * D * 4 <= WS_H && WS_H + (size_t)M * D * 2 <= WS_QKVG && WS_QKVG + (size_t)M * INW * 2 <= WS_END, "d_ws map");
static_assert((size_t)M * 1024 * 2 <= 66 * MiB && (size_t)DEPTH * NSEQ * MODW * 4 <= 6 * MiB && (size_t)FF2 * D * 2 <= 44 * MiB && (size_t)D * FF * 2 <= 22 * MiB, "d_ws map 2");
constexpr int CW_TMO = 0, CW_BAR = 4096;

constexpr int RING_OFF = 0, RING_BYTES = 131072;
constexpr int LDSCTL_OFF = RING_BYTES, MISC_OFF = LDSCTL_OFF + 320;
constexpr int LDS_BYTES = 147456;
constexpr int NWAVES = 8, NTHREADS = 512;

#define GAS __attribute__((address_space(1)))
#define LAS __attribute__((address_space(3)))
typedef unsigned short bf16;
typedef unsigned v4u __attribute__((ext_vector_type(4)));
typedef unsigned v2u __attribute__((ext_vector_type(2)));
typedef float f32x4 __attribute__((ext_vector_type(4)));
typedef float f32x2v __attribute__((ext_vector_type(2)));
typedef float f32x16 __attribute__((ext_vector_type(16)));
typedef short bf16x8 __attribute__((ext_vector_type(8)));
typedef short s16x4 __attribute__((ext_vector_type(4)));
typedef __bf16 bf16x2_t __attribute__((ext_vector_type(2)));
typedef GAS unsigned gu32;
#define RLX_AGENT __ATOMIC_RELAXED, __HIP_MEMORY_SCOPE_AGENT
#define LDS_WAIT() asm volatile("s_waitcnt lgkmcnt(0)" ::: "memory")

__device__ __forceinline__ unsigned pk2(float lo, float hi) { f32x2v v = {lo, hi}; bf16x2_t b = __builtin_convertvector(v, bf16x2_t); return __builtin_bit_cast(unsigned, b); }
__device__ __forceinline__ float bflo(unsigned u) { return __uint_as_float(u << 16); }
__device__ __forceinline__ float bfhi(unsigned u) { return __uint_as_float(u & 0xffff0000u); }
__device__ __forceinline__ float sigm(float x) { return __builtin_amdgcn_rcpf(1.f + __expf(-x)); }
__device__ __forceinline__ int row_seq(int row) { return row < MP ? (row >> 12) : NBP + ((row - MP) >> 5); }

namespace pg8 {
#define PG8_LAS __attribute__((address_space(3)))
typedef unsigned short bf16_t;
typedef short bf16x8 __attribute__((ext_vector_type(8)));
typedef float f32x4 __attribute__((ext_vector_type(4)));
typedef unsigned u32x4 __attribute__((ext_vector_type(4)));
constexpr int BM = 256, BK = 64, HALF = 128, HTB = HALF * BK * 2  , STAGE_BYTES = 8 * HTB, NXCD = 8, WGM = 8;

__host__ __device__ __forceinline__ int lds_byte(int r, int c) { const int st = (r >> 4) * 2 + (c >> 5), rr = r & 15, cc = c & 31, ob = rr * 64 + cc * 2; return st * 1024 + (ob ^ (((ob >> 9) & 1) << 5)); }
__host__ __device__ __forceinline__ void stage_rc(int b, int& R, int& C) { const int st = b / 1024, sb = b % 1024, swz = sb ^ (((sb >> 9) & 1) << 5); R = (st >> 1) * 16 + swz / 64; C = (st & 1) * 32 + (swz % 64) / 2; }
__host__ __device__ __forceinline__ int perm32(int rho) { const int n = rho >> 4, i = rho & 15; return 8 * (i >> 2) + 4 * n + (i & 3); }

struct Unit { int pm, pn; };
struct Gemm { const bf16_t* A; const bf16_t* Bt; int M, N, K; };

struct StaticOrder {
    int nM, nN, nwg, G, c;
    __host__ __device__ void init(int M, int N, int G_, int c_) { nM = M / BM; nN = N / BM; nwg = nM * nN; G = G_; c = c_; }
    __host__ __device__ bool next(int i, Unit& u) const {
        const long L = (long)i * G + c; if (L >= nwg) return false;
        int wgid = (int)L; { const int q = nwg / NXCD, r = nwg % NXCD, xcd = wgid % NXCD, off = wgid / NXCD; wgid = (xcd < r ? xcd * (q + 1) : r * (q + 1) + (xcd - r) * q) + off; }
        const int nig = WGM * nN, gid = wgid / nig, fm = gid * WGM, gsz = (nM - fm) < WGM ? (nM - fm) : WGM;
        u.pm = fm + ((wgid % nig) % gsz); u.pn = (wgid % nig) / gsz; return true;
    }
    __device__ __forceinline__ void a_ready(const Unit&) const {}
    __device__ __forceinline__ void done(const Unit&) const {}
};

#define EPI_FENCE() do {} while (0)
template <class T> __device__ __forceinline__ T* at(T* base, unsigned byte_off) { return (T*)((char*)base + byte_off); }
template <class T> __device__ __forceinline__ const T* at(const T* base, unsigned byte_off) { return (const T*)((const char*)base + byte_off); }

struct EpiIn {
    static constexpr bool PERM = true, AFTER_DRAIN = false;
    bf16_t* QKVG; float* out; int layer;
    __device__ __forceinline__ void operator()(const f32x4 (&acc)[2][2][4][2], const Unit& u, int wr, int wc, int fr, int fq) const {
        const int reg = u.pn >> 2;
        const int rl0 = wr * 64 + fr, cl0 = wc * 32 + 8 * fq;
        bf16_t* tb = QKVG + (size_t)u.pm * BM * INW + (size_t)u.pn * BM;
        unsigned lo = (unsigned)(rl0 * INW + cl0) * 2u; asm volatile("" : "+v"(lo));
        if (reg >= 6) {
#pragma unroll
            for (int ai = 0; ai < 2; ++ai)
#pragma unroll
                for (int m = 0; m < 4; ++m) {
#pragma unroll
                    for (int bj = 0; bj < 2; ++bj) {
                        const f32x4 v0 = acc[ai][bj][m][0], v1 = acc[ai][bj][m][1];
                        u32x4 w; w.x = pk2(sigm(v0[0]), sigm(v0[1])); w.y = pk2(sigm(v0[2]), sigm(v0[3])); w.z = pk2(sigm(v1[0]), sigm(v1[1])); w.w = pk2(sigm(v1[2]), sigm(v1[3]));
                        *(u32x4*)at(tb, lo + (unsigned)((ai * HALF + m * 16) * INW + bj * HALF) * 2u) = w;
                    }
                    EPI_FENCE();
                }
            return;
        }
        const float sc = (reg == 0) ? SCALE_A : (reg == 3 ? SCALE_B : 1.f);
        float* fo = nullptr;
        const bool samp = u.pm >= MP / BM;
        const size_t tr0 = samp ? (size_t)(u.pm - MP / BM) * BM : 0;
        const int rc = (u.pn & 3) * BM;
        if (reg == 1 || reg == 2) fo = samp ? out + (reg == 1 ? O_AKS : O_AVS) + ((size_t)layer * MS + tr0) * 1024 + rc
                                            : out + (reg == 1 ? O_AKP : O_AVP) + ((size_t)layer * MP + (size_t)u.pm * BM) * 1024 + rc;
        if (reg == 4 || reg == 5) {
            if (samp) fo = out + (reg == 4 ? O_BKS : O_BVS) + ((size_t)layer * MS + tr0) * 1024 + rc;
            else if ((u.pm & 15) >= 14) fo = out + (reg == 4 ? O_BKP : O_BVP) + ((size_t)(layer * NBP + (u.pm >> 4)) * 512 + (size_t)((u.pm & 15) - 14) * 256) * 1024 + rc;
        }
        unsigned fl = (unsigned)(rl0 * 1024 + cl0) * 4u; asm volatile("" : "+v"(fl));
#pragma unroll
        for (int ai = 0; ai < 2; ++ai)
#pragma unroll
            for (int m = 0; m < 4; ++m) {
#pragma unroll
                for (int bj = 0; bj < 2; ++bj) {
                    f32x4 v0 = acc[ai][bj][m][0], v1 = acc[ai][bj][m][1];
                    if (fo) { float* fp = at(fo, fl + (unsigned)((ai * HALF + m * 16) * 1024 + bj * HALF) * 4u); *(f32x4*)fp = v0; *(f32x4*)(fp + 4) = v1; }
                    v0 = v0 * sc; v1 = v1 * sc;
                    u32x4 w; w.x = pk2(v0[0], v0[1]); w.y = pk2(v0[2], v0[3]); w.z = pk2(v1[0], v1[1]); w.w = pk2(v1[2], v1[3]);
                    *(u32x4*)at(tb, lo + (unsigned)((ai * HALF + m * 16) * INW + bj * HALF) * 2u) = w;
                }
                EPI_FENCE();
            }
    }
};

template <bool ADD> struct EpiGate {
    static constexpr bool PERM = true, AFTER_DRAIN = false;
    bf16_t* MG; const bf16_t* G; int gcol;
    __device__ __forceinline__ void operator()(const f32x4 (&acc)[2][2][4][2], const Unit& u, int wr, int wc, int fr, int fq) const {
        const int rl0 = wr * 64 + fr, cl0 = wc * 32 + 8 * fq;
        bf16_t* mb = MG + (size_t)u.pm * BM * D + (size_t)u.pn * BM;
        const bf16_t* gb = G + (size_t)u.pm * BM * INW + gcol + (size_t)u.pn * BM;
        unsigned mo = (unsigned)(rl0 * D + cl0) * 2u, go = (unsigned)(rl0 * INW + cl0) * 2u; asm volatile("" : "+v"(mo), "+v"(go));
#pragma unroll
        for (int ai = 0; ai < 2; ++ai)
#pragma unroll
            for (int m = 0; m < 4; ++m) {
#pragma unroll
                for (int bj = 0; bj < 2; ++bj) {
                    const u32x4 g = *(const u32x4*)at(gb, go + (unsigned)((ai * HALF + m * 16) * INW + bj * HALF) * 2u);
                    const f32x4 a0 = acc[ai][bj][m][0], a1 = acc[ai][bj][m][1];
                    float r0 = a0[0] * bflo(g.x), r1 = a0[1] * bfhi(g.x), r2 = a0[2] * bflo(g.y), r3 = a0[3] * bfhi(g.y);
                    float r4 = a1[0] * bflo(g.z), r5 = a1[1] * bfhi(g.z), r6 = a1[2] * bflo(g.w), r7 = a1[3] * bfhi(g.w);
                    bf16_t* mp = at(mb, mo + (unsigned)((ai * HALF + m * 16) * D + bj * HALF) * 2u);
                    if (ADD) { const u32x4 o = *(const u32x4*)mp;
                        r0 += bflo(o.x); r1 += bfhi(o.x); r2 += bflo(o.y); r3 += bfhi(o.y); r4 += bflo(o.z); r5 += bfhi(o.z); r6 += bflo(o.w); r7 += bfhi(o.w); }
                    u32x4 w; w.x = pk2(r0, r1); w.y = pk2(r2, r3); w.z = pk2(r4, r5); w.w = pk2(r6, r7);
                    *(u32x4*)mp = w;
                }
                EPI_FENCE();
            }
    }
};

struct EpiRes {
    static constexpr bool PERM = false, AFTER_DRAIN = false;
    const float* xp; const float* xs; const float* gate; float* outp;
    __device__ __forceinline__ void operator()(const f32x4 (&acc)[2][2][4][2], const Unit& u, int wr, int wc, int fr, int fq) const {
        const int rl0 = wr * 64 + fr, cl0 = wc * 32 + 4 * fq;
        const bool samp = u.pm >= MP / BM;
        const float* xb = (samp ? xs + (size_t)(u.pm - MP / BM) * BM * D : xp + (size_t)u.pm * BM * D) + (size_t)u.pn * BM;
        float* ob = outp + (size_t)u.pm * BM * D + (size_t)u.pn * BM;
        const float* gbase = gate + (size_t)(samp ? NBP + 8 * (u.pm - MP / BM) : (u.pm >> 4)) * MODW + (size_t)u.pn * BM;
        unsigned xo = (unsigned)(rl0 * D + cl0) * 4u, gl = (unsigned)cl0 * 4u; asm volatile("" : "+v"(xo), "+v"(gl));
#pragma unroll
        for (int ai = 0; ai < 2; ++ai)
#pragma unroll
            for (int m = 0; m < 4; ++m) {
                const unsigned go = gl + (samp ? (unsigned)((rl0 + ai * HALF + m * 16) >> 5) * (unsigned)(MODW * 4) : 0u);
#pragma unroll
                for (int bj = 0; bj < 2; ++bj)
#pragma unroll
                    for (int n = 0; n < 2; ++n) {
                        const unsigned co = (unsigned)(bj * HALF + n * 16) * 4u, ro = (unsigned)((ai * HALF + m * 16) * D) * 4u;
                        const f32x4 x = *(const f32x4*)at(xb, xo + ro + co), g = *(const f32x4*)at(gbase, go + co);
                        *(f32x4*)at(ob, xo + ro + co) = x * ALPHA + g * acc[ai][bj][m][n];
                    }
                EPI_FENCE();
            }
    }
};

struct EpiSwiGLU {
    static constexpr bool PERM = true, AFTER_DRAIN = false;
    bf16_t* HID;
    __device__ __forceinline__ void operator()(const f32x4 (&acc)[2][2][4][2], const Unit& u, int wr, int wc, int fr, int fq) const {
        const int rl0 = wr * 64 + fr, cl0 = wc * 32 + 8 * fq;
        bf16_t* hb = HID + (size_t)u.pm * BM * FF + (size_t)u.pn * HALF;
        unsigned ho = (unsigned)(rl0 * FF + cl0) * 2u; asm volatile("" : "+v"(ho));
#pragma unroll
        for (int ai = 0; ai < 2; ++ai)
#pragma unroll
            for (int m = 0; m < 4; ++m) {
                float r[8];
#pragma unroll
                for (int n = 0; n < 2; ++n)
#pragma unroll
                    for (int e = 0; e < 4; ++e) { const float a = acc[ai][0][m][n][e], b = acc[ai][1][m][n][e]; r[4 * n + e] = a * sigm(a) * b; }
                u32x4 w; w.x = pk2(r[0], r[1]); w.y = pk2(r[2], r[3]); w.z = pk2(r[4], r[5]); w.w = pk2(r[6], r[7]);
                *(u32x4*)at(hb, ho + (unsigned)((ai * HALF + m * 16) * FF) * 2u) = w;
                EPI_FENCE();
            }
    }
};

template <class Epi, class Sched, bool ALIGN_EPI = false, bool SP2 = false>
__device__ __forceinline__ void gemm_phase(PG8_LAS unsigned char* lds, const Gemm g, const Sched& S, const Epi& E) {
    int tid_ = threadIdx.x; asm volatile("" : "+v"(tid_));
    const int tid = tid_, wid = __builtin_amdgcn_readfirstlane(tid >> 6), lane = tid & 63, wr = wid >> 2, wc = wid & 3, fr = lane & 15, fq = lane >> 4;
    const int K = g.K, nt = K / BK;
    unsigned voffA[2], voffB[2];
#pragma unroll
    for (int i = 0; i < 2; ++i) { int R, C; stage_rc(tid * 16 + i * 8192, R, C); const int Rb = Epi::PERM ? ((R & ~31) + perm32(R & 31)) : R;
        voffA[i] = (unsigned)(R * K + C) * 2u; voffB[i] = (unsigned)(Rb * K + C) * 2u; }
    const size_t kstep = (size_t)(BK * 2);
    const size_t hstep = (size_t)HALF * K * 2;
    const size_t tstep = 2 * hstep;
    const unsigned ldsw = (unsigned)wid * 1024u;
    const int aoff = lds_byte(wr * 64 + fr, fq * 8), boff = lds_byte(wc * 32 + fr, fq * 8);
#define PG8_SA(b, h) (((b) * 2 + (h)) * HTB)
#define PG8_SB(b, h) ((4 + (b) * 2 + (h)) * HTB)
#define PG8_STAGE(bufoff, gbase, voff) do { _Pragma("unroll") for (int _i = 0; _i < 2; ++_i) \
        __builtin_amdgcn_global_load_lds((const unsigned*)((const char*)(gbase) + (voff)[_i]), (PG8_LAS unsigned*)(lds + (bufoff) + ldsw + _i * 8192), 16, 0, 0); } while (0)
#define PG8_LDA(dst, b, h) do { _Pragma("unroll") for (int m = 0; m < 4; ++m) _Pragma("unroll") for (int k = 0; k < 2; ++k) dst[m][k] = *(const PG8_LAS bf16x8*)(lds + PG8_SA(b, h) + aoff + m * 2048 + k * 1024); } while (0)
#define PG8_LDB(dst, b, h) do { _Pragma("unroll") for (int n = 0; n < 2; ++n) _Pragma("unroll") for (int k = 0; k < 2; ++k) dst[n][k] = *(const PG8_LAS bf16x8*)(lds + PG8_SB(b, h) + boff + n * 2048 + k * 1024); } while (0)
#define PG8_MMA(ai, bj, At, Bt) do { __builtin_amdgcn_s_setprio(1); _Pragma("unroll") for (int m = 0; m < 4; ++m) _Pragma("unroll") for (int n = 0; n < 2; ++n) _Pragma("unroll") for (int k = 0; k < 2; ++k) \
        acc[ai][bj][m][n] = __builtin_amdgcn_mfma_f32_16x16x32_bf16(Bt[n][k], At[m][k], acc[ai][bj][m][n], 0, 0, 0); __builtin_amdgcn_s_setprio(0); } while (0)
#define PG8_WAIT_V(n) asm volatile("s_waitcnt vmcnt(" #n ")" ::: "memory")
#define PG8_WAIT_L(n) asm volatile("s_waitcnt lgkmcnt(" #n ")" ::: "memory")
#define PG8_BAR __builtin_amdgcn_s_barrier()
#define PG8_SCHED __builtin_amdgcn_sched_barrier(0)
    Unit cur, nxt; int ui = 0;
    if (!S.next(0, cur)) return;
    f32x4 acc[2][2][4][2];
#pragma unroll
    for (int a = 0; a < 2; ++a)
#pragma unroll
        for (int b = 0; b < 2; ++b)
#pragma unroll
            for (int m = 0; m < 4; ++m)
#pragma unroll
                for (int n = 0; n < 2; ++n) acc[a][b][m][n] = (f32x4){0.f, 0.f, 0.f, 0.f};
    bf16x8 At[4][2], B0[2][2], B1[2][2];
    const char* cA = (const char*)g.A + (size_t)cur.pm * tstep; const char* cB = (const char*)g.Bt + (size_t)cur.pn * tstep;
    S.a_ready(cur);
    if constexpr (SP2) {
        PG8_STAGE(PG8_SB(0, 0), cB, voffB); PG8_STAGE(PG8_SB(0, 1), cB + hstep, voffB); PG8_STAGE(PG8_SA(0, 0), cA, voffA); PG8_STAGE(PG8_SA(0, 1), cA + hstep, voffA);
        if (wr == 1) PG8_BAR;
        PG8_WAIT_V(2); PG8_BAR;
        PG8_STAGE(PG8_SB(1, 0), cB + kstep, voffB); PG8_STAGE(PG8_SA(1, 0), cA + kstep, voffA); PG8_STAGE(PG8_SB(1, 1), cB + hstep + kstep, voffB);
        PG8_WAIT_V(6); PG8_BAR;
    } else {
        PG8_STAGE(PG8_SB(0, 0), cB, voffB); PG8_STAGE(PG8_SA(0, 0), cA, voffA); PG8_STAGE(PG8_SB(0, 1), cB + hstep, voffB); PG8_STAGE(PG8_SA(0, 1), cA + hstep, voffA);
        if (wr == 1) PG8_BAR;
        PG8_WAIT_V(4); PG8_BAR;
        PG8_STAGE(PG8_SB(1, 0), cB + kstep, voffB); PG8_STAGE(PG8_SA(1, 0), cA + kstep, voffA); PG8_STAGE(PG8_SB(1, 1), cB + hstep + kstep, voffB);
        PG8_WAIT_V(6); PG8_BAR;
    }
    for (;;) {
        const bool has_next = S.next(ui + 1, nxt);
        const char* nA = has_next ? (const char*)g.A + (size_t)nxt.pm * tstep : cA; const char* nB = has_next ? (const char*)g.Bt + (size_t)nxt.pn * tstep : cB;
        for (int t = 0; t < nt; t += 2) {
            const bool last = (t == nt - 2);
            const char* a1 = cA + (size_t)(t + 1) * kstep;
            const char* a2 = last ? nA : cA + (size_t)(t + 2) * kstep; const char* b2 = last ? nB : cB + (size_t)(t + 2) * kstep;
            const char* a3 = a2 + kstep; const char* b3 = b2 + kstep;
            if (last && has_next) S.a_ready(nxt);
            if constexpr (SP2) {
            PG8_LDB(B0, 0, 0); PG8_LDB(B1, 0, 1); PG8_SCHED; PG8_LDA(At, 0, 0); PG8_STAGE(PG8_SA(1, 1), a1 + hstep, voffA);
            PG8_WAIT_V(8); PG8_WAIT_L(0); PG8_BAR; PG8_MMA(0, 0, At, B0); PG8_MMA(0, 1, At, B1); PG8_BAR; PG8_SCHED;
            PG8_LDA(At, 0, 1); PG8_STAGE(PG8_SB(0, 0), b2, voffB); PG8_STAGE(PG8_SB(0, 1), b2 + hstep, voffB); PG8_STAGE(PG8_SA(0, 0), a2, voffA);
            PG8_WAIT_V(8); PG8_WAIT_L(0); PG8_BAR; PG8_MMA(1, 0, At, B0); PG8_MMA(1, 1, At, B1); PG8_BAR; PG8_SCHED;
            PG8_LDB(B0, 1, 0); PG8_LDB(B1, 1, 1); PG8_SCHED; PG8_LDA(At, 1, 0); PG8_STAGE(PG8_SA(0, 1), a2 + hstep, voffA);
            PG8_WAIT_V(8); PG8_WAIT_L(0); PG8_BAR; PG8_MMA(0, 0, At, B0); PG8_MMA(0, 1, At, B1); PG8_BAR; PG8_SCHED;
            PG8_LDA(At, 1, 1); PG8_STAGE(PG8_SB(1, 0), b3, voffB); PG8_STAGE(PG8_SB(1, 1), b3 + hstep, voffB); PG8_STAGE(PG8_SA(1, 0), a3, voffA);
            PG8_WAIT_V(8); PG8_WAIT_L(0); PG8_BAR; PG8_MMA(1, 0, At, B0); PG8_MMA(1, 1, At, B1); PG8_BAR; PG8_SCHED;
            } else {
            PG8_LDB(B0, 0, 0); PG8_SCHED; PG8_LDA(At, 0, 0); PG8_STAGE(PG8_SA(1, 1), a1 + hstep, voffA);
            PG8_WAIT_L(8); PG8_BAR; PG8_WAIT_L(0); PG8_MMA(0, 0, At, B0); PG8_BAR; PG8_SCHED;
            PG8_LDB(B1, 0, 1); PG8_STAGE(PG8_SB(0, 0), b2, voffB);
            PG8_BAR; PG8_WAIT_L(0); PG8_MMA(0, 1, At, B1); PG8_BAR;
            PG8_LDA(At, 0, 1); PG8_STAGE(PG8_SA(0, 0), a2, voffA);
            PG8_BAR; PG8_WAIT_L(0); PG8_MMA(1, 0, At, B0); PG8_BAR; PG8_SCHED;
            PG8_STAGE(PG8_SB(0, 1), b2 + hstep, voffB);
            PG8_WAIT_V(6); PG8_BAR; PG8_MMA(1, 1, At, B1); PG8_BAR;
            PG8_LDB(B0, 1, 0); PG8_SCHED; PG8_LDA(At, 1, 0); PG8_STAGE(PG8_SA(0, 1), a2 + hstep, voffA);
            PG8_WAIT_L(8); PG8_BAR; PG8_WAIT_L(0); PG8_MMA(0, 0, At, B0); PG8_BAR; PG8_SCHED;
            PG8_LDB(B1, 1, 1); PG8_STAGE(PG8_SB(1, 0), b3, voffB);
            PG8_BAR; PG8_WAIT_L(0); PG8_MMA(0, 1, At, B1); PG8_BAR;
            PG8_LDA(At, 1, 1); PG8_STAGE(PG8_SA(1, 0), a3, voffA);
            PG8_BAR; PG8_WAIT_L(0); PG8_MMA(1, 0, At, B0); PG8_BAR; PG8_SCHED;
            PG8_STAGE(PG8_SB(1, 1), b3 + hstep, voffB);
            PG8_WAIT_V(6); PG8_BAR; PG8_MMA(1, 1, At, B1); PG8_BAR;
            }
        }
        if constexpr (ALIGN_EPI) { if (wr == 0) PG8_BAR; }
        if constexpr (!Epi::AFTER_DRAIN) { E(acc, cur, wr, wc, fr, fq); S.done(cur); }
        if (!has_next) break;
#pragma unroll
        for (int a = 0; a < 2; ++a)
#pragma unroll
            for (int b = 0; b < 2; ++b)
#pragma unroll
                for (int m = 0; m < 4; ++m)
#pragma unroll
                    for (int n = 0; n < 2; ++n) acc[a][b][m][n] = (f32x4){0.f, 0.f, 0.f, 0.f};
        cur = nxt; cA = nA; cB = nB; ++ui;
        if constexpr (ALIGN_EPI) { if (wr == 1) PG8_BAR; }
    }
    PG8_WAIT_V(0);
    if constexpr (!ALIGN_EPI) { if (wr == 0) PG8_BAR; }
    PG8_BAR;
    if constexpr (Epi::AFTER_DRAIN) { E.fused(acc, cur, wr, wc, fr, fq, lds, wid, lane); S.done(cur); }
#undef PG8_SA
#undef PG8_SB
#undef PG8_STAGE
#undef PG8_LDA
#undef PG8_LDB
#undef PG8_MMA
#undef PG8_WAIT_V
#undef PG8_WAIT_L
#undef PG8_BAR
#undef PG8_SCHED
}
}

namespace att {
constexpr int L_K = 0, L_V = 32768, L_TAB = 65536, L_XCH = 0;
__device__ __forceinline__ unsigned off_b(unsigned row, unsigned ch) { return 256u * row + 16u * (ch ^ (((row & 3u) << 2) | ((row >> 2) & 3u))); }
#define MFMA32(a, b, c) __builtin_amdgcn_mfma_f32_32x32x16_bf16((a), (b), (c), 0, 0, 0)
__device__ __forceinline__ s16x4 vtr(const LAS unsigned char* p) { return __builtin_bit_cast(s16x4, __builtin_amdgcn_ds_read_tr16_b64_v4i16((LAS s16x4*)p)); }

struct Ctx {
    const bf16* QKVG;
    const float *cak, *cav, *cbk, *cbv;
    bf16 *OA, *OB;
    const float* subln;
    float lam, osc;
};

__device__ __forceinline__ void build_tables(LAS unsigned char* lds, const float* t5, const float* relb  ) {
    LAS float* tab = (LAS float*)(lds + L_TAB);
    int tid_ = threadIdx.x; asm volatile("" : "+v"(tid_));
#pragma unroll 1
    for (int e = tid_; e < 2 * 8 * 256; e += NTHREADS) {
        const int mode = e >> 11, hh = (e >> 8) & 7, idx = e & 255, rel = idx - 191;
        float v;
        if (mode == 0) {
            const int n = rel < 0 ? -rel : rel;
            int bk = n < 8 ? n : (n < 12 ? 8 : n < 16 ? 9 : n < 23 ? 10 : n < 32 ? 11 : n < 46 ? 12 : n < 64 ? 13 : n < 91 ? 14 : 15);
            if (rel > 0) bk += 16;
            v = t5[bk * 8 + hh];
        } else {
            int rb = rel < -128 ? -128 : (rel > 128 ? 128 : rel);
            v = relb[(rb + 128) * 8 + hh];
        }
        tab[e] = v * LOG2E;
    }
    __syncthreads();
}

template <int MODE, bool SAMPLE>
__device__ __forceinline__ void unit(LAS unsigned char* lds, const Ctx& C, const int b, const int hh, const int u) {
    constexpr int DK = MODE == 0 ? 64 : 128, NS = DK / 16;
    int tid_ = threadIdx.x; asm volatile("" : "+v"(tid_));
    const int tid = tid_, lane = tid & 63, wid = __builtin_amdgcn_readfirstlane(tid >> 6);
    const int r = lane & 31, h = lane >> 5;
    int t = 0, cw, p_lo, p_hi, wp_lo = 0, qrow0, qpos0; bool has = true;
    if (MODE == 0 && !SAMPLE) { t = wid & 1; const int sub = wid >> 1; qpos0 = 128 * u + 32 * sub; qrow0 = b * SEQ + qpos0; cw = 2 * u + (sub >> 1); p_lo = 0; p_hi = 2 * u + 1; }
    if (MODE == 1 && !SAMPLE) { qpos0 = 256 * u + 32 * wid; qrow0 = b * SEQ + qpos0; cw = 4 * u + (wid >> 1); p_lo = 4 * u - 8 < 0 ? 0 : 4 * u - 8; p_hi = 4 * u + 3; wp_lo = cw - 8; }
    if (MODE == 0 && SAMPLE) { t = wid & 1; has = (wid >> 1) == 0; qpos0 = PAST; qrow0 = MP + b * TS; cw = 16; p_lo = 0; p_hi = 16; }
    if (MODE == 1 && SAMPLE) { has = wid == 0; qpos0 = PAST; qrow0 = MP + b * TS; cw = 16; p_lo = 8; p_hi = 16; wp_lo = 8; }
    const LAS float* tab = (const LAS float*)(lds + L_TAB) + (MODE * 8 + hh) * 256;
    const float cfar = tab[0];
    bf16x8 qf[NS];
    {
        const bf16* qp = C.QKVG + (size_t)(qrow0 + r) * INW + (MODE == 0 ? C_QA + hh * 128 + t * 64 : C_QB + hh * 128) + 8 * h;
#pragma unroll
        for (int s = 0; s < NS; ++s) qf[s] = has ? *(const bf16x8*)(qp + 16 * s) : (bf16x8){0, 0, 0, 0, 0, 0, 0, 0};
    }
    float mrun = -INFINITY, lsum = 0.f;
    f32x16 o[4];
#pragma unroll
    for (int c = 0; c < 4; ++c)
#pragma unroll
        for (int i = 0; i < 16; ++i) o[c][i] = 0.f;
    const unsigned xk = ((unsigned)(r & 3) << 2) | ((unsigned)(r >> 2) & 3u);
    const int q4 = (lane & 15) >> 2, p4 = lane & 3, blk = (lane >> 4) & 1;
    unsigned vbase[2][4];
#pragma unroll
    for (int tt = 0; tt < 2; ++tt)
#pragma unroll
        for (int c = 0; c < 4; ++c) {
            const unsigned ch = (unsigned)(4 * c + 2 * blk + (p4 >> 1)), x = ((unsigned)q4 << 2) | ((unsigned)(2 * tt + h) & 3u);
            vbase[tt][c] = 256u * (unsigned)(8 * tt + 4 * h + q4) + 16u * (ch ^ x) + 8u * (unsigned)(p4 & 1);
        }
    const int kcol = (MODE == 0 ? C_KA : C_KB) + hh * 128, vcol = (MODE == 0 ? C_VA : C_VB) + hh * 128;

    for (int p = p_lo; p <= p_hi; ++p) {
        const int buf = (p - p_lo) & 1;
        LAS unsigned char* Kt = lds + L_K + buf * 16384;
        LAS unsigned char* Vt = lds + L_V + buf * 16384;
        if (SAMPLE && p < 16) {
            const float* ck = (MODE == 0 ? C.cak + ((size_t)b * PAST + 64 * p) * 1024 : C.cbk + ((size_t)b * BPAST + 64 * (p - 8)) * 1024) + hh * 128;
            const float* cv = (MODE == 0 ? C.cav + ((size_t)b * PAST + 64 * p) * 1024 : C.cbv + ((size_t)b * BPAST + 64 * (p - 8)) * 1024) + hh * 128;
#pragma unroll
            for (int i = 0; i < 2; ++i) {
                const int id = tid + NTHREADS * i, row = id >> 4, ch = id & 15;
                const f32x4 k0 = *(const f32x4*)(ck + (size_t)row * 1024 + ch * 8), k1 = *(const f32x4*)(ck + (size_t)row * 1024 + ch * 8 + 4);
                const f32x4 v0 = *(const f32x4*)(cv + (size_t)row * 1024 + ch * 8), v1 = *(const f32x4*)(cv + (size_t)row * 1024 + ch * 8 + 4);
                v4u kw, vw; kw.x = pk2(k0[0], k0[1]); kw.y = pk2(k0[2], k0[3]); kw.z = pk2(k1[0], k1[1]); kw.w = pk2(k1[2], k1[3]);
                vw.x = pk2(v0[0], v0[1]); vw.y = pk2(v0[2], v0[3]); vw.z = pk2(v1[0], v1[1]); vw.w = pk2(v1[2], v1[3]);
                const unsigned off = off_b((unsigned)row, (unsigned)ch);
                *(LAS v4u*)(Kt + off) = kw; *(LAS v4u*)(Vt + off) = vw;
            }
        } else {
            const int nvalid = SAMPLE ? TS : 64;
            const size_t grow0 = SAMPLE ? (size_t)(MP + b * TS) : (size_t)b * SEQ + (size_t)64 * p;
#pragma unroll
            for (int i = 0; i < 2; ++i) {
                const int id = tid + NTHREADS * i, row = id >> 4, ch = id & 15;
                if (row < nvalid) {
                    const bf16* src = C.QKVG + (grow0 + row) * INW + ch * 8;
                    const v4u kw = *(const v4u*)(src + kcol), vw = *(const v4u*)(src + vcol);
                    const unsigned off = off_b((unsigned)row, (unsigned)ch);
                    *(LAS v4u*)(Kt + off) = kw; *(LAS v4u*)(Vt + off) = vw;
                }
            }
        }
        __syncthreads();
        if (has && p >= wp_lo && p <= cw) {
            const int nkb = (SAMPLE && p == 16) ? 1 : 2;
            const bool nearb = p >= cw - 2;
            f32x16 sx[2];
#pragma unroll
            for (int kb = 0; kb < 2; ++kb) {
                if (kb < nkb) {
                    const float ini = nearb ? 0.f : cfar;
#pragma unroll
                    for (int i = 0; i < 16; ++i) sx[kb][i] = ini;
#pragma unroll
                    for (int s = 0; s < NS; ++s) {
                        const unsigned ch = (unsigned)(2 * ((MODE == 0 ? 4 * t : 0) + s) + h);
                        const bf16x8 kf = *(const LAS bf16x8*)(Kt + 256u * (unsigned)(32 * kb + r) + 16u * (ch ^ xk));
                        sx[kb] = MFMA32(kf, qf[s], sx[kb]);
                    }
                    if (nearb) {
                        const LAS float* tp = tab + (64 * p + 32 * kb + 4 * h - (qpos0 + r) + 191);
#pragma unroll
                        for (int i = 0; i < 16; ++i) sx[kb][i] += tp[(i & 3) + 8 * (i >> 2)];
                    }
                } else {
#pragma unroll
                    for (int i = 0; i < 16; ++i) sx[kb][i] = -INFINITY;
                }
            }
            float mx = sx[0][0];
#pragma unroll
            for (int kb = 0; kb < 2; ++kb)
#pragma unroll
                for (int i = 0; i < 16; ++i) mx = fmaxf(mx, sx[kb][i]);
            mx = fmaxf(mx, __shfl_xor(mx, 32));
            const float mn = fmaxf(mrun, mx);
            const float al = __builtin_amdgcn_exp2f(mrun - mn);
            mrun = mn;
            float ps = 0.f;
#pragma unroll
            for (int kb = 0; kb < 2; ++kb)
#pragma unroll
                for (int i = 0; i < 16; ++i) { const float e = __builtin_amdgcn_exp2f(sx[kb][i] - mn); sx[kb][i] = e; ps += e; }
            lsum = lsum * al + ps;
            if (!__all(al == 1.f)) {
#pragma unroll
                for (int c = 0; c < 4; ++c)
#pragma unroll
                    for (int i = 0; i < 16; ++i) o[c][i] *= al;
            }
#pragma unroll
            for (int kb = 0; kb < 2; ++kb) {
                if (kb < nkb) {
#pragma unroll
                    for (int s2 = 0; s2 < 2; ++s2) {
                        v4u pw; pw.x = pk2(sx[kb][8 * s2 + 0], sx[kb][8 * s2 + 1]); pw.y = pk2(sx[kb][8 * s2 + 2], sx[kb][8 * s2 + 3]);
                        pw.z = pk2(sx[kb][8 * s2 + 4], sx[kb][8 * s2 + 5]); pw.w = pk2(sx[kb][8 * s2 + 6], sx[kb][8 * s2 + 7]);
                        const bf16x8 pf = __builtin_bit_cast(bf16x8, pw);
                        const LAS unsigned char* vb = Vt + 256 * (32 * kb + 16 * s2);
#pragma unroll
                        for (int c = 0; c < 4; ++c) {
                            const s16x4 lo = vtr(vb + vbase[0][c]), hi = vtr(vb + vbase[1][c]);
                            const bf16x8 vf = __builtin_shufflevector(lo, hi, 0, 1, 2, 3, 4, 5, 6, 7);
                            o[c] = MFMA32(vf, pf, o[c]);
                        }
                    }
                }
            }
        }
    }
    lsum += __shfl_xor(lsum, 32);
    const float il = has ? 1.f / lsum : 0.f;
    if (MODE == 1) {
        if (has) {
            bf16* op = C.OB + (size_t)(qrow0 + r) * 1024 + hh * 128 + 4 * h;
#pragma unroll
            for (int c = 0; c < 4; ++c)
#pragma unroll
                for (int g = 0; g < 4; ++g) {
                    v2u w; w.x = pk2(o[c][4 * g] * il, o[c][4 * g + 1] * il); w.y = pk2(o[c][4 * g + 2] * il, o[c][4 * g + 3] * il);
                    *(v2u*)(op + 32 * c + 8 * g) = w;
                }
        }
        __syncthreads();
    } else {
        const int sub = wid >> 1;
        LAS float* xch = (LAS float*)(lds + L_XCH) + sub * 4096;
        __syncthreads();
        if (has && t == 1) {
#pragma unroll
            for (int c = 0; c < 4; ++c)
#pragma unroll
                for (int i = 0; i < 16; ++i) xch[(32 * c + 8 * (i >> 2) + 4 * h + (i & 3)) * 32 + r] = o[c][i] * il;
        }
        __syncthreads();
        if (has && t == 0) {
            float ss = 0.f;
#pragma unroll
            for (int c = 0; c < 4; ++c)
#pragma unroll
                for (int i = 0; i < 16; ++i) { const float v = o[c][i] * il - C.lam * xch[(32 * c + 8 * (i >> 2) + 4 * h + (i & 3)) * 32 + r]; o[c][i] = v; ss += v * v; }
            ss += __shfl_xor(ss, 32);
            const float rs = C.osc / sqrtf(ss * (1.f / 128.f) + LN_EPS);
            bf16* op = C.OA + (size_t)(qrow0 + r) * 1024 + hh * 128 + 4 * h;
#pragma unroll
            for (int c = 0; c < 4; ++c)
#pragma unroll
                for (int g = 0; g < 4; ++g) {
                    const f32x4 gn = *(const f32x4*)(C.subln + 32 * c + 8 * g + 4 * h);
                    v2u w; w.x = pk2(o[c][4 * g] * rs * gn[0], o[c][4 * g + 1] * rs * gn[1]); w.y = pk2(o[c][4 * g + 2] * rs * gn[2], o[c][4 * g + 3] * rs * gn[3]);
                    *(v2u*)(op + 32 * c + 8 * g) = w;
                }
        }
        __syncthreads();
    }
}
#undef MFMA32
}

#define XB_TMO      128
#define XB_XCNT(j)  (256  + 64 * (j))
#define XB_XSUB(j)  (1280 + 64 * (j))
#define XB_XGEN(j)  (2304 + 64 * (j))
#define XB_TOP      3328
#define XB_TOPGEN   3392
#define XCD_BAR_WORDS 3456
#define XB_SPIN_CAP (1u << 22)

__device__ __forceinline__ unsigned xb_ld(unsigned* p)              { return __hip_atomic_load(p, __ATOMIC_RELAXED, __HIP_MEMORY_SCOPE_AGENT); }
__device__ __forceinline__ unsigned xb_add(unsigned* p, unsigned v) { return __hip_atomic_fetch_add(p, v, __ATOMIC_RELAXED, __HIP_MEMORY_SCOPE_AGENT); }
__device__ __forceinline__ unsigned xb_xcc_id() { return (unsigned)__builtin_amdgcn_s_getreg((3 << 11) | 20) & 0xFu; }
#define XB_SPIN(cond, bar) do { unsigned _sp = 0; while (cond) { __builtin_amdgcn_s_sleep(1); \
    if ((++_sp & 255u) == 0u) { if (xb_ld(&(bar)[XB_TMO])) break; if (_sp > XB_SPIN_CAP) { atomicAdd(&(bar)[XB_TMO], 1u); break; } } } } while (0)

struct XcdBarrier {
    unsigned* bar; unsigned x;
    volatile LAS unsigned* st;
};

__device__ __forceinline__ XcdBarrier xcd_barrier_post(unsigned* bar, volatile LAS unsigned* st) {
    XcdBarrier b; b.bar = bar; b.x = xb_xcc_id(); b.st = st;
    if (threadIdx.x == 0) (void)xb_add(&bar[XB_XCNT(b.x)], 1u);
    return b;
}
__device__ __forceinline__ void xcd_barrier_complete(unsigned* bar, unsigned x, unsigned& nloc, unsigned& nx) {
    const unsigned G = gridDim.x * gridDim.y * gridDim.z;
    unsigned sum, cnt, mine, sp = 0u;
    for (;;) {
        sum = 0u; cnt = 0u; mine = 0u;
#pragma unroll
        for (unsigned j = 0; j < 16; ++j) { const unsigned c = xb_ld(&bar[XB_XCNT(j)]); sum += c; cnt += (c > 0u) ? 1u : 0u; mine = (j == x) ? c : mine; }
        if (sum == G) break;
        __builtin_amdgcn_s_sleep(1);
        if ((++sp & 255u) == 0u) { if (xb_ld(&bar[XB_TMO])) break; if (sp > XB_SPIN_CAP) { atomicAdd(&bar[XB_TMO], 1u); break; } }
    }
    nloc = mine > 0u ? mine : 1u; nx = cnt > 0u ? cnt : 1u;
}

__device__ __forceinline__ void xcd_barrier(const XcdBarrier& b) {
    asm volatile("s_waitcnt vmcnt(0)" ::: "memory");
    __syncthreads();
    if (threadIdx.x == 0) {
        unsigned* bar = b.bar;
        __builtin_amdgcn_s_waitcnt(0);
        unsigned nloc = b.st[0], nx = b.st[1];
        if (nloc == 0u) { xcd_barrier_complete(bar, b.x, nloc, nx); b.st[0] = nloc; b.st[1] = nx; }
        const unsigned old = xb_add(&bar[XB_XSUB(b.x)], 1u);
        const unsigned gen = old / nloc;
        if (old + 1u == (gen + 1u) * nloc) {
            __builtin_amdgcn_fence(__ATOMIC_RELEASE, "agent");
            asm volatile("s_waitcnt vmcnt(0)" ::: "memory");
            const unsigned og = xb_add(&bar[XB_TOP], 1u);
            const unsigned tg = og / nx;
            if (og + 1u == (tg + 1u) * nx) xb_add(&bar[XB_TOPGEN], 1u);
            else XB_SPIN(xb_ld(&bar[XB_TOPGEN]) == tg, bar);
            __builtin_amdgcn_fence(__ATOMIC_ACQUIRE, "agent");
            xb_add(&bar[XB_XGEN(b.x)], 1u);
            asm volatile("s_waitcnt vmcnt(0)" ::: "memory");
        } else {
            XB_SPIN(xb_ld(&bar[XB_XGEN(b.x)]) == gen, bar);
            __builtin_amdgcn_fence(__ATOMIC_ACQUIRE, "agent");
            asm volatile("s_waitcnt vmcnt(0)" ::: "memory");
        }
    }
    __syncthreads();
}

struct Frame {
    LAS unsigned char* lds;
    volatile LAS unsigned* MISC;
    gu32* ctl;
    int tid, lane, wave, vcu, G;
    float* out; unsigned char* ws;
};
struct Args { const float* in[N_IN]; float* out; unsigned char* ws; int ph_lo, ph_hi; };
__device__ __forceinline__ float wave_sum(float v) {
#pragma unroll
    for (int o = 1; o < 64; o <<= 1) v += __shfl_xor(v, o);
    return v;
}
__device__ __forceinline__ bf16* wcopy(const Frame& F, int l, size_t off) { return (bf16*)(F.ws + WS_W + (size_t)l * WS_WL + off); }
__device__ __forceinline__ float* modp(const Frame& F, int l) { return (float*)(F.ws + WS_MOD) + (size_t)l * NSEQ * MODW; }

__device__ __forceinline__ void transpose_item(const float* W, int N, bf16* WT, int K, int k0, int n0, int dst_row0, LAS float* scr, int lane) {
#pragma unroll 8
    for (int i = 0; i < 32; ++i) { const int kk = 2 * i + (lane >> 5); scr[kk * 33 + (lane & 31)] = W[(size_t)(k0 + kk) * N + n0 + (lane & 31)]; }
    LDS_WAIT(); asm volatile("" ::: "memory");
    const int c = lane & 7;
#pragma unroll
    for (int j = 0; j < 4; ++j) { const int n = (lane >> 3) + 8 * j; const LAS float* s = scr + (8 * c) * 33 + n;
        v4u o; o.x = pk2(s[0 * 33], s[1 * 33]); o.y = pk2(s[2 * 33], s[3 * 33]); o.z = pk2(s[4 * 33], s[5 * 33]); o.w = pk2(s[6 * 33], s[7 * 33]);
        *(GAS v4u*)(WT + (size_t)(dst_row0 + n) * K + k0 + 8 * c) = o; }
    LDS_WAIT(); asm volatile("" ::: "memory");
}
__device__ __forceinline__ void p0_weights(Frame& F, const Args& A) {
    LAS float* scr = (LAS float*)(F.lds + RING_OFF + F.wave * 16384);
    const int gw = F.vcu * NWAVES + F.wave, NGW = F.G * NWAVES;
    constexpr int I_IN = 32 * 320, I_OA = 16 * 64, I_OUT = 32 * 64, I_1 = 32 * 176, I_2 = 88 * 64, I_LAYER = I_IN + 2 * I_OA + I_OUT + 2 * I_1 + I_2;
    for (int it = gw; it < DEPTH * I_LAYER; it += NGW) {
        const int l = it / I_LAYER; int r = it % I_LAYER;
        if (r < I_IN) { transpose_item(A.in[I_WIN] + (size_t)l * D * INW, INW, wcopy(F, l, WO_WIN), D, 64 * (r / 320), 32 * (r % 320), 32 * (r % 320), scr, F.lane); continue; } r -= I_IN;
        if (r < I_OA) { transpose_item(A.in[I_WOA] + (size_t)l * 1024 * D, D, wcopy(F, l, WO_WOA), 1024, 64 * (r / 64), 32 * (r % 64), 32 * (r % 64), scr, F.lane); continue; } r -= I_OA;
        if (r < I_OA) { transpose_item(A.in[I_WOB] + (size_t)l * 1024 * D, D, wcopy(F, l, WO_WOB), 1024, 64 * (r / 64), 32 * (r % 64), 32 * (r % 64), scr, F.lane); continue; } r -= I_OA;
        if (r < I_OUT) { transpose_item(A.in[I_WOUT] + (size_t)l * D * D, D, wcopy(F, l, WO_WOUT), D, 64 * (r / 64), 32 * (r % 64), 32 * (r % 64), scr, F.lane); continue; } r -= I_OUT;
        if (r < I_1) { const int n0 = 32 * (r % 176); transpose_item(A.in[I_W1] + (size_t)l * D * FF, FF, wcopy(F, l, WO_W13), D, 64 * (r / 176), n0, 256 * (n0 / 128) + (n0 % 128), scr, F.lane); continue; } r -= I_1;
        if (r < I_1) { const int n0 = 32 * (r % 176); transpose_item(A.in[I_W3] + (size_t)l * D * FF, FF, wcopy(F, l, WO_W13), D, 64 * (r / 176), n0, 256 * (n0 / 128) + 128 + (n0 % 128), scr, F.lane); continue; } r -= I_1;
        transpose_item(A.in[I_W2] + (size_t)l * FF * D, D, wcopy(F, l, WO_W2), FF, 64 * (r / 64), 32 * (r % 64), 32 * (r % 64), scr, F.lane);
    }
}
__device__ __forceinline__ void p0_mod(Frame& F, const Args& A) {
    LAS float* SC = (LAS float*)(F.lds + RING_OFF);
    const int col = F.lane & 31, kh = F.lane >> 5;
    for (int it = blockIdx.x; it < DEPTH * (MODW / 32); it += gridDim.x) {
        const int l = it / (MODW / 32), n0 = (it % (MODW / 32)) * 32;
        const float* W = A.in[I_WMOD] + (size_t)l * D * MODW + n0 + col;
        float acc[NSEQ];
#pragma unroll
        for (int s = 0; s < NSEQ; ++s) acc[s] = 0.f;
        for (int kq = 0; kq < 4; ++kq) {
            __syncthreads();
            { const int k = kq * 512 + F.tid;
#pragma unroll
              for (int s = 0; s < NSEQ; ++s) { const float c = (s < NBP ? A.in[I_CP] + (size_t)s * D : A.in[I_CS] + (size_t)(s - NBP) * D)[k]; SC[F.tid * NSEQ + s] = c / (1.f + __expf(-c)); } }
            __syncthreads();
#pragma unroll 4
            for (int i = 0; i < 32; ++i) {
                const int kl = F.wave * 64 + 2 * i + kh;
                const float w = W[(size_t)(kq * 512 + kl) * MODW];
                const LAS f32x4* sp = (const LAS f32x4*)(SC + kl * NSEQ);
#pragma unroll
                for (int j = 0; j < NSEQ / 4; ++j) { const f32x4 v = sp[j]; acc[4 * j] += v[0] * w; acc[4 * j + 1] += v[1] * w; acc[4 * j + 2] += v[2] * w; acc[4 * j + 3] += v[3] * w; }
            }
        }
        __syncthreads();
        LAS float* RED = SC;
#pragma unroll
        for (int s = 0; s < NSEQ; ++s) { const float v = acc[s] + __shfl_xor(acc[s], 32); if (kh == 0) RED[(F.wave * NSEQ + s) * 32 + col] = v; }
        __syncthreads();
        for (int o = F.tid; o < NSEQ * 32; o += NTHREADS) { const int s = o >> 5, c2 = o & 31; float v = 0.f;
#pragma unroll
            for (int w = 0; w < NWAVES; ++w) v += RED[(w * NSEQ + s) * 32 + c2];
            modp(F, l)[(size_t)s * MODW + n0 + c2] = v + A.in[I_BMOD][(size_t)l * MODW + n0 + c2]; }
    }
    __syncthreads();
    if (blockIdx.x == 0 && F.tid < DEPTH) {
        const int l = F.tid; float s1 = 0.f, s2 = 0.f;
        for (int i = 0; i < 64; ++i) { s1 += A.in[I_LQ1][l * 64 + i] * A.in[I_LK1][l * 64 + i]; s2 += A.in[I_LQ2][l * 64 + i] * A.in[I_LK2][l * 64 + i]; }
        const float lam_init = 0.8f - 0.6f * expf(-0.3f * (float)l);
        ((float*)(F.ws + WS_MISC))[l] = expf(s1) - expf(s2) + lam_init;
    }
}
__device__ __forceinline__ void ln_stats(const f32x4 (&v)[8], float& mean, float& rstd) {
    float s = 0.f;
#pragma unroll
    for (int j = 0; j < 8; ++j) s += (v[j][0] + v[j][1]) + (v[j][2] + v[j][3]);
    mean = wave_sum(s) * (1.f / D); float q = 0.f;
#pragma unroll
    for (int j = 0; j < 8; ++j) { const f32x4 d = v[j] - mean; q += (d[0] * d[0] + d[1] * d[1]) + (d[2] * d[2] + d[3] * d[3]); }
    rstd = 1.f / sqrtf(wave_sum(q) * (1.f / D) + LN_EPS);
}
template <int KIND>
__device__ __forceinline__ void ln_phase(Frame& F, const float* xp, const float* xs, float* inout, const float* gain, const float* bias, const float* mrow, bf16* H) {
    const int gw = F.vcu * NWAVES + F.wave, NGW = F.G * NWAVES;
    int lane_ = F.lane; asm volatile("" : "+v"(lane_)); const int lane = lane_;
    for (int row = gw; row < M; row += NGW) {
        f32x4 v[8]; float mean, rstd;
        const float* src = KIND == 0 ? (row < MP ? xp + (size_t)row * D : xs + (size_t)(row - MP) * D) : inout + (size_t)row * D;
#pragma unroll
        for (int j = 0; j < 8; ++j) v[j] = *(const f32x4*)(src + 4 * lane + 256 * j);
        ln_stats(v, mean, rstd);
        if (KIND == 1) {
            float* dst = inout + (size_t)row * D;
#pragma unroll
            for (int j = 0; j < 8; ++j) { const f32x4 g = *(const f32x4*)(gain + 4 * lane + 256 * j), bb = *(const f32x4*)(bias + 4 * lane + 256 * j);
                v[j] = (v[j] - mean) * rstd * g + bb; *(f32x4*)(dst + 4 * lane + 256 * j) = v[j]; }
            if (mrow) ln_stats(v, mean, rstd);
        }
        if (mrow) {
            const float* mr = mrow + (size_t)row_seq(row) * MODW;
            bf16* hp = H + (size_t)row * D;
#pragma unroll
            for (int j = 0; j < 8; ++j) { const f32x4 sh = *(const f32x4*)(mr + 4 * lane + 256 * j), sc = *(const f32x4*)(mr + D + 4 * lane + 256 * j);
                const f32x4 o = (v[j] - mean) * rstd * (sc + 1.f) + sh;
                v2u w; w.x = pk2(o[0], o[1]); w.y = pk2(o[2], o[3]); *(v2u*)(hp + 4 * lane + 256 * j) = w; }
        }
    }
}

__device__ __forceinline__ void attn_phase(Frame& F, const Args& A, int l) {
    att::build_tables(F.lds + RING_OFF, A.in[I_T5], A.in[I_REL] + (size_t)l * 257 * 8);
    att::Ctx C;
    C.QKVG = (const bf16*)(F.ws + WS_QKVG);
    C.cak = A.in[I_CAK] + (size_t)l * NBS * PAST * 1024; C.cav = A.in[I_CAV] + (size_t)l * NBS * PAST * 1024;
    C.cbk = A.in[I_CBK] + (size_t)l * NBS * BPAST * 1024; C.cbv = A.in[I_CBV] + (size_t)l * NBS * BPAST * 1024;
    C.OA = (bf16*)(F.ws + WS_OA); C.OB = (bf16*)(F.ws + WS_OB);
    C.subln = A.in[I_SUBLN] + l * 128;
    C.lam = ((const float*)(F.ws + WS_MISC))[l];
    C.osc = 1.f - (0.8f - 0.6f * expf(-0.3f * (float)l));
    LAS unsigned char* lds = F.lds + RING_OFF;
#ifndef ATT_MASK
#define ATT_MASK 15
#endif
    if (ATT_MASK & 1) for (int pi = F.vcu; pi < 1024; pi += F.G) {
        const int bh = pi >> 4, s = pi & 15;
        att::unit<0, false>(lds, C, bh >> 3, bh & 7, 31 - s);
        att::unit<0, false>(lds, C, bh >> 3, bh & 7, s);
    }
    if (ATT_MASK & 2) for (int bi = F.vcu; bi < 1024; bi += F.G) {
        const int bh = bi >> 4;
        att::unit<1, false>(lds, C, bh >> 3, bh & 7, bi & 15);
    }
    if (ATT_MASK & 4) for (int si = F.vcu; si < NBS * 8; si += F.G) att::unit<0, true>(lds, C, si >> 3, si & 7, 0);
    if (ATT_MASK & 8) for (int si = F.vcu; si < NBS * 8; si += F.G) att::unit<1, true>(lds, C, si >> 3, si & 7, 0);
}

#ifndef MK_PER_PHASE
#define MK_PER_PHASE 0
#endif
constexpr int N_PHASES = 2 + 8 * DEPTH;
__global__ void __launch_bounds__(NTHREADS, 2) fwd_kernel(Args args) {
    extern __shared__ __attribute__((aligned(16))) unsigned char lds[];
    Frame F;
    F.lds = (LAS unsigned char*)lds;
    F.MISC = (volatile LAS unsigned*)(F.lds + MISC_OFF);
    F.tid = threadIdx.x; F.lane = F.tid & 63; F.wave = __builtin_amdgcn_readfirstlane(F.tid >> 6);
    F.G = gridDim.x; { const int bx = blockIdx.x; F.vcu = (F.G % 8 == 0) ? (bx % 8) * (F.G / 8) + bx / 8 : bx; }
    F.out = args.out; F.ws = args.ws;
    F.ctl = (gu32*)(F.ws + WS_CTL);
    for (int u = F.tid; u < (LDS_BYTES - LDSCTL_OFF) / 4; u += NTHREADS) ((LAS unsigned*)(F.lds + LDSCTL_OFF))[u] = 0u;
    __syncthreads();
    XcdBarrier bar; bar.bar = (unsigned*)(F.ctl + CW_BAR); bar.x = 0; bar.st = nullptr;
    if (!MK_PER_PHASE) bar = xcd_barrier_post((unsigned*)(F.ctl + CW_BAR), F.MISC + 8);
    const int lo = args.ph_lo, hi = args.ph_hi;
#ifndef PH_MASK
#define PH_MASK 0xffffffffu
#endif
#define PHM(j) ((PH_MASK >> (j)) & 1u)
#define IN(k) (lo <= (k) && (k) < hi)
#define SEAM(k) do { if (IN(k) && IN((k) + 1)) xcd_barrier(bar); } while (0)

    bf16* const Hb = (bf16*)(F.ws + WS_H);
    bf16* const QKVG = (bf16*)(F.ws + WS_QKVG);
    float* const XB = (float*)(F.ws + WS_XB);
    float* const Y = F.out + O_YP;
    LAS unsigned char* const ring = F.lds + RING_OFF;

    if (PHM(0) && IN(0)) { p0_weights(F, args); __syncthreads(); }
    if (PHM(10) && IN(0)) { p0_mod(F, args); }
    SEAM(0);
    if (PHM(1) && IN(1)) ln_phase<0>(F, args.in[I_XP], args.in[I_XS], nullptr, nullptr, nullptr, modp(F, 0), Hb);
    SEAM(1);
#pragma unroll 1
    for (int l = 0; l < DEPTH; ++l) {
        const int pb = 2 + 8 * l;
        const float* xin_p = l == 0 ? args.in[I_XP] : Y;
        const float* xin_s = l == 0 ? args.in[I_XS] : Y + (size_t)MP * D;
        if (PHM(2) && IN(pb + 0)) {
            pg8::Gemm g{Hb, wcopy(F, l, WO_WIN), M, INW, D}; pg8::StaticOrder S; S.init(M, INW, F.G, (int)blockIdx.x);
            pg8::EpiIn E{QKVG, F.out, l};
            pg8::gemm_phase<pg8::EpiIn, pg8::StaticOrder, true, true>(ring, g, S, E);
        }
        SEAM(pb + 0);
        if (PHM(3) && IN(pb + 1)) attn_phase(F, args, l);
        SEAM(pb + 1);
        if (PHM(4) && IN(pb + 2)) {
            { pg8::Gemm g{(const bf16*)(F.ws + WS_OA), wcopy(F, l, WO_WOA), M, D, 1024}; pg8::StaticOrder S; S.init(M, D, F.G, (int)blockIdx.x);
              pg8::EpiGate<false> E{Hb, QKVG, C_GA};
              pg8::gemm_phase<pg8::EpiGate<false>, pg8::StaticOrder, true, true>(ring, g, S, E); }
            { pg8::Gemm g{(const bf16*)(F.ws + WS_OB), wcopy(F, l, WO_WOB), M, D, 1024}; pg8::StaticOrder S; S.init(M, D, F.G, (int)blockIdx.x);
              pg8::EpiGate<true> E{Hb, QKVG, C_GB};
              pg8::gemm_phase<pg8::EpiGate<true>, pg8::StaticOrder, true, true>(ring, g, S, E); }
        }
        SEAM(pb + 2);
        if (PHM(5) && IN(pb + 3)) {
            pg8::Gemm g{Hb, wcopy(F, l, WO_WOUT), M, D, D}; pg8::StaticOrder S; S.init(M, D, F.G, (int)blockIdx.x);
            pg8::EpiRes E{xin_p, xin_s, modp(F, l) + 2 * D, XB};
            pg8::gemm_phase<pg8::EpiRes, pg8::StaticOrder, true, true>(ring, g, S, E);
        }
        SEAM(pb + 3);
        if (PHM(6) && IN(pb + 4)) ln_phase<1>(F, nullptr, nullptr, XB, args.in[I_LN1G] + l * D, args.in[I_LN1B] + l * D, modp(F, l) + 3 * D, Hb);
        SEAM(pb + 4);
        if (PHM(7) && IN(pb + 5)) {
            pg8::Gemm g{Hb, wcopy(F, l, WO_W13), M, FF2, D}; pg8::StaticOrder S; S.init(M, FF2, F.G, (int)blockIdx.x);
            pg8::EpiSwiGLU E{QKVG};
            pg8::gemm_phase<pg8::EpiSwiGLU, pg8::StaticOrder, true, true>(ring, g, S, E);
        }
        SEAM(pb + 5);
        if (PHM(8) && IN(pb + 6)) {
            pg8::Gemm g{QKVG, wcopy(F, l, WO_W2), M, D, FF}; pg8::StaticOrder S; S.init(M, D, F.G, (int)blockIdx.x);
            pg8::EpiRes E{XB, XB + (size_t)MP * D, modp(F, l) + 5 * D, Y};
            pg8::gemm_phase<pg8::EpiRes, pg8::StaticOrder, true, true>(ring, g, S, E);
        }
        SEAM(pb + 6);
        if (PHM(9) && IN(pb + 7)) ln_phase<1>(F, nullptr, nullptr, Y, args.in[I_LN2G] + l * D, args.in[I_LN2B] + l * D, l + 1 < DEPTH ? modp(F, l + 1) : nullptr, Hb);
        if (l + 1 < DEPTH) SEAM(pb + 7);
    }
#undef IN
#undef SEAM
}

extern "C" void kernel_launch(void* const* d_in, const int* in_sizes, int n_in, void* d_out, int out_size, void* d_ws, size_t ws_size, hipStream_t stream) {
    static int grid = 0;
    if (grid == 0) {
        if (n_in != N_IN || in_sizes[0] != MP * D || (size_t)out_size != O_TOTAL || ws_size < WS_END) {
            fprintf(stderr, "kernel_launch: unexpected problem: n_in %d in0 %d out %d ws %zu (need %zu); nothing launched\n", n_in, n_in > 0 ? in_sizes[0] : -1, out_size, ws_size, (size_t)WS_END); grid = -1; return; }
        int dev = 0, cus = 0, per_cu = 0;
        if (hipGetDevice(&dev) != hipSuccess || hipDeviceGetAttribute(&cus, hipDeviceAttributeMultiprocessorCount, dev) != hipSuccess) { grid = -1; return; }
        if (hipFuncSetAttribute((const void*)fwd_kernel, hipFuncAttributeMaxDynamicSharedMemorySize, LDS_BYTES) != hipSuccess) { fprintf(stderr, "kernel_launch: hipFuncSetAttribute failed\n"); grid = -1; return; }
        if (hipOccupancyMaxActiveBlocksPerMultiprocessor(&per_cu, (const void*)fwd_kernel, NTHREADS, LDS_BYTES) != hipSuccess || per_cu < 1)
            fprintf(stderr, "kernel_launch: note: occupancy query reports %d workgroups per CU\n", per_cu);
        (void)hipGetLastError();
        grid = cus;
    }
    if (grid < 0) return;
    if (hipMemsetAsync((char*)d_ws + WS_CTL, 0, CTL_ZERO_BYTES, stream) != hipSuccess) return;
    Args a{};
    for (int i = 0; i < N_IN; ++i) a.in[i] = (const float*)d_in[i];
    a.out = (float*)d_out; a.ws = (unsigned char*)d_ws;
#if MK_PER_PHASE
    for (int p = 0; p < N_PHASES; ++p) { a.ph_lo = p; a.ph_hi = p + 1; hipLaunchKernelGGL(fwd_kernel, dim3(grid), dim3(NTHREADS), LDS_BYTES, stream, a); }
#else
    a.ph_lo = 0; a.ph_hi = N_PHASES;
    hipLaunchKernelGGL(fwd_kernel, dim3(grid), dim3(NTHREADS), LDS_BYTES, stream, a);
#endif
    const hipError_t le = hipPeekAtLastError();
    if (le != hipSuccess) fprintf(stderr, "kernel_launch: launch failed: %s\n", hipGetErrorName(le));
}
```

```cpp
#include <hip/hip_runtime.h>
#include <hip/hip_bf16.h>
#include <cstdio>
#include <cstdint>
#include <cmath>

constexpr int D = 2048, NBP = 8, SEQ = 4096, NBS = 32, TS = 32, PAST = 1024, BPAST = 512, DEPTH = 2;
constexpr int MP = NBP * SEQ, MS = NBS * TS, M = MP + MS;
constexpr int NSEQ = NBP + NBS;
constexpr int INW = 10240, FF = 5632, FF2 = 2 * FF, MODW = 6 * D;
constexpr int C_QA = 0, C_KA = 1024, C_VA = 2048, C_QB = 3072, C_KB = 4096, C_VB = 5120, C_GA = 6144, C_GB = 8192;
constexpr float LN_EPS = 1e-5f;
constexpr float ALPHA = 1.4142135623730951f;
constexpr float LOG2E = 1.4426950408889634f;
constexpr float SCALE_A = 0.18033688011112042f;
constexpr float SCALE_B = 0.12751743082459868f;
constexpr size_t O_YP = 0, O_YS = 67108864, O_AKP = 69206016, O_AVP = 136314880, O_BKP = 203423744, O_BVP = 211812352,
                 O_AKS = 220200960, O_AVS = 222298112, O_BKS = 224395264, O_BVS = 226492416, O_TOTAL = 228589568;
enum { I_XP = 0, I_XS, I_CAK, I_CAV, I_CBK, I_CBV, I_CP, I_CS, I_WMOD, I_BMOD, I_WIN, I_LQ1, I_LK1, I_LQ2, I_LK2, I_SUBLN, I_T5, I_REL, I_WOA, I_WOB, I_WOUT,
       I_LN1G, I_LN1B, I_W1, I_W3, I_W2, I_LN2G, I_LN2B, N_IN };

constexpr size_t MiB = 1u << 20;
constexpr size_t WS_CTL = 0, CTL_ZERO_BYTES = 32768;
constexpr size_t WS_MISC = 1 * MiB;
constexpr size_t WS_MOD = 2 * MiB;
constexpr size_t WS_W = 8 * MiB, WS_WL = 122 * MiB;
constexpr size_t WO_WIN = 0, WO_WOA = 40 * MiB, WO_WOB = 44 * MiB, WO_WOUT = 48 * MiB, WO_W13 = 56 * MiB, WO_W2 = 100 * MiB;
constexpr size_t WS_XB = 256 * MiB;
constexpr size_t WS_OA = WS_XB, WS_OB = WS_XB + 66 * MiB;
constexpr size_t WS_H = 520 * MiB;
constexpr size_t WS_QKVG = 652 * MiB;
constexpr size_t WS_END = 1312 * MiB;
static_assert(WS_W + 2 * WS_WL <= WS_XB && WS_XB + (size_t)M * D * 4 <= WS_H && WS_H + (size_t)M * D * 2 <= WS_QKVG && WS_QKVG + (size_t)M * INW * 2 <= WS_END, "d_ws map");
static_assert((size_t)M * 1024 * 2 <= 66 * MiB && (size_t)DEPTH * NSEQ * MODW * 4 <= 6 * MiB && (size_t)FF2 * D * 2 <= 44 * MiB && (size_t)D * FF * 2 <= 22 * MiB, "d_ws map 2");
constexpr int CW_TMO = 0, CW_BAR = 4096;
static_assert((CW_BAR + 3456) * 4 <= (int)CTL_ZERO_BYTES, "barrier words inside the per-call memset");

constexpr int RING_OFF = 0, RING_BYTES = 131072;
constexpr int LDSCTL_OFF = RING_BYTES, MISC_OFF = LDSCTL_OFF + 320;
constexpr int LDS_BYTES = 147456;
constexpr int NWAVES = 8, NTHREADS = 512;

#define GAS __attribute__((address_space(1)))
#define LAS __attribute__((address_space(3)))
typedef unsigned short bf16;
typedef unsigned v4u __attribute__((ext_vector_type(4)));
typedef unsigned v2u __attribute__((ext_vector_type(2)));
typedef float f32x4 __attribute__((ext_vector_type(4)));
typedef float f32x2v __attribute__((ext_vector_type(2)));
typedef float f32x16 __attribute__((ext_vector_type(16)));
typedef short bf16x8 __attribute__((ext_vector_type(8)));
typedef short s16x4 __attribute__((ext_vector_type(4)));
typedef __bf16 bf16x2_t __attribute__((ext_vector_type(2)));
typedef GAS unsigned gu32;
#define RLX_AGENT __ATOMIC_RELAXED, __HIP_MEMORY_SCOPE_AGENT
#define LDS_WAIT() asm volatile("s_waitcnt lgkmcnt(0)" ::: "memory")

__device__ __forceinline__ unsigned pk2(float lo, float hi) { f32x2v v = {lo, hi}; bf16x2_t b = __builtin_convertvector(v, bf16x2_t); return __builtin_bit_cast(unsigned, b); }
__device__ __forceinline__ float bflo(unsigned u) { return __uint_as_float(u << 16); }
__device__ __forceinline__ float bfhi(unsigned u) { return __uint_as_float(u & 0xffff0000u); }
__device__ __forceinline__ float sigm(float x) { return __builtin_amdgcn_rcpf(1.f + __expf(-x)); }
__device__ __forceinline__ int row_seq(int row) { return row < MP ? (row >> 12) : NBP + ((row - MP) >> 5); }

namespace pg8 {
#define PG8_LAS __attribute__((address_space(3)))
typedef unsigned short bf16_t;
typedef short bf16x8 __attribute__((ext_vector_type(8)));
typedef float f32x4 __attribute__((ext_vector_type(4)));
typedef unsigned u32x4 __attribute__((ext_vector_type(4)));
constexpr int BM = 256, BK = 64, HALF = 128, HTB = HALF * BK * 2  , STAGE_BYTES = 8 * HTB, NXCD = 8, WGM = 8;

__host__ __device__ __forceinline__ int lds_byte(int r, int c) { const int st = (r >> 4) * 2 + (c >> 5), rr = r & 15, cc = c & 31, ob = rr * 64 + cc * 2; return st * 1024 + (ob ^ (((ob >> 9) & 1) << 5)); }
__host__ __device__ __forceinline__ void stage_rc(int b, int& R, int& C) { const int st = b / 1024, sb = b % 1024, swz = sb ^ (((sb >> 9) & 1) << 5); R = (st >> 1) * 16 + swz / 64; C = (st & 1) * 32 + (swz % 64) / 2; }
__host__ __device__ __forceinline__ int perm32(int rho) { const int n = rho >> 4, i = rho & 15; return 8 * (i >> 2) + 4 * n + (i & 3); }

struct Unit { int pm, pn, kt0, nkt, part; };
struct Gemm { const bf16_t* A; const bf16_t* Bt; int M, N, K; };

struct StaticOrder {
    int nM, nN, nwg, G, c;
    int nkt_all;
    __host__ __device__ void init(int M, int N, int G_, int c_, int K = 0) { nM = M / BM; nN = N / BM; nwg = nM * nN; G = G_; c = c_; nkt_all = K / BK; }
    __host__ __device__ bool next(int i, Unit& u) const {
        const long L = (long)i * G + c; if (L >= nwg) return false;
        int wgid = (int)L; { const int q = nwg / NXCD, r = nwg % NXCD, xcd = wgid % NXCD, off = wgid / NXCD; wgid = (xcd < r ? xcd * (q + 1) : r * (q + 1) + (xcd - r) * q) + off; }
        const int nig = WGM * nN, gid = wgid / nig, fm = gid * WGM, gsz = (nM - fm) < WGM ? (nM - fm) : WGM;
        u.pm = fm + ((wgid % nig) % gsz); u.pn = (wgid % nig) / gsz; u.kt0 = 0; u.nkt = nkt_all; u.part = 0;
        u.pn = (u.pn + gid * (nN / NXCD)) % nN;
        return true;
    }
    __host__ __device__ int count() const { return c < nwg ? (nwg - 1 - c) / G + 1 : 0; }
    __host__ __device__ int count0() const { return (nwg - 1) / G + 1; }
    __device__ __forceinline__ void a_ready(const Unit&) const {}
    __device__ __forceinline__ void done(const Unit&) const {}
};
struct ShiftedTailOrder {
    StaticOrder base; int c, whole, T; unsigned* flags;
    __device__ void init(int M, int N, int G_, int c_, int K, unsigned* fl) { base.init(M, N, G_, c_, K); c = c_; whole = base.nwg / G_; T = base.nwg - whole * G_; flags = fl; if (2 * T > G_ || T == 0) T = -1; }
    __device__ bool next(int i, Unit& u) const {
        if (T < 0 || i < whole) return base.next(i, u);
        if (i == whole && c >= T && c < 2 * T) { StaticOrder b2 = base; b2.c = c - T; const bool ok = b2.next(whole, u); u.part = 9; return ok; }
        return false;
    }
    __device__ int count() const { return T < 0 ? base.count() : whole + ((c >= T && c < 2 * T) ? 1 : 0); }
    __device__ int count0() const { return base.count0(); }
    __device__ __forceinline__ void a_ready(const Unit& u) const {
        if (u.part != 9) return;
        const gu32* fw = (const gu32*)flags + (c - T);
        for (int spin = 0; spin < (1 << 22); ++spin) { if (__hip_atomic_load(fw, RLX_AGENT) != 0u) break; __builtin_amdgcn_s_sleep(2); }
        __builtin_amdgcn_fence(__ATOMIC_ACQUIRE, "agent");
    }
    __device__ __forceinline__ void done(const Unit&) const {}
};
struct TailOrder {
    StaticOrder base; int S, c, G; bool rev;
    __host__ __device__ void init(int N, int G_, int c_, int K, int S_, bool rev_ = false) { base.init(MP, N, G_, c_, K); S = S_; c = c_; G = G_; rev = rev_; }
    __host__ __device__ bool next(int i, Unit& u) const {
        const int nb = base.count();
        if (i < nb) { const bool ok = base.next(i, u); if (rev) u.pm = MP / BM - 1 - u.pm; return ok; }
        if (i > nb || c >= 32 * S) return false;
        const int tile = c / S, p = c % S, nt = base.nkt_all;
        u.pm = MP / BM + tile / base.nN; u.pn = tile % base.nN;
        u.kt0 = (p * nt / S) & ~1; u.nkt = (((p + 1) * nt / S) & ~1) - u.kt0; if (p == S - 1) u.nkt = nt - u.kt0; u.part = p + 1;
        return true;
    }
    __host__ __device__ int count() const { return base.count() + (c < 32 * S ? 1 : 0); }
    __host__ __device__ int count0() const { return base.count0() + 1; }
    __device__ __forceinline__ void a_ready(const Unit&) const {}
    __device__ __forceinline__ void done(const Unit&) const {}
};

#define EPI_FENCE() do {} while (0)
#ifndef PG8_EREP_IN
#define PG8_EREP_IN 1
#endif
#ifndef PG8_EREP_RES
#define PG8_EREP_RES 1
#endif
#ifndef PG8_EREP_SW
#define PG8_EREP_SW 1
#endif
#ifndef PG8_KREP_IN
#define PG8_KREP_IN 1
#endif
#ifndef PG8_KREP_RES
#define PG8_KREP_RES 1
#endif
#define EPI_STEP(off, pitch_bytes, m) do { off += (unsigned)(((m) == 3 ? HALF - 48 : 16) * (pitch_bytes)); asm volatile("" : "+v"(off)); } while (0)
#ifndef EPI_NT
#define EPI_NT 0
#endif
#if EPI_NT
#define EPI_ST(ptr, w) __builtin_nontemporal_store((w), (GAS u32x4*)(ptr))
#else
#define EPI_ST(ptr, w) (*(GAS u32x4*)(ptr) = (w))
#endif
template <class T> __device__ __forceinline__ GAS T* at(T* base, unsigned byte_off) { return (GAS T*)((GAS char*)base + byte_off); }
template <class T> __device__ __forceinline__ const GAS T* at(const T* base, unsigned byte_off) { return (const GAS T*)((const GAS char*)base + byte_off); }

struct EpiIn {
    static constexpr bool PERM = true, AFTER_DRAIN = false; static constexpr int KREP = PG8_KREP_IN, EREP = PG8_EREP_IN;
    bf16_t* QKVG; float* out; int layer;
    __device__ __forceinline__ void operator()(const f32x4 (&acc)[2][2][4][2], const Unit& u, int wr, int wc, int fr, int fq) const {
        const int reg = u.pn >> 2;
        const int rl0 = wr * 64 + fr, cl0 = wc * 32 + 8 * fq;
        bf16_t* tb = QKVG + (size_t)u.pm * BM * INW + (size_t)u.pn * BM;
        unsigned lo = (unsigned)(rl0 * INW + cl0) * 2u; asm volatile("" : "+v"(lo));
        if (reg >= 6) {
#pragma unroll
            for (int ai = 0; ai < 2; ++ai)
#pragma unroll
                for (int m = 0; m < 4; ++m) {
#pragma unroll
                    for (int bj = 0; bj < 2; ++bj) {
                        const f32x4 v0 = acc[ai][bj][m][0] * (1.f / KREP), v1 = acc[ai][bj][m][1] * (1.f / KREP);
                        u32x4 w; w.x = pk2(sigm(v0[0]), sigm(v0[1])); w.y = pk2(sigm(v0[2]), sigm(v0[3])); w.z = pk2(sigm(v1[0]), sigm(v1[1])); w.w = pk2(sigm(v1[2]), sigm(v1[3]));
                        EPI_ST(at(tb, lo + (unsigned)(bj * HALF) * 2u), w);
                    }
                    EPI_STEP(lo, INW * 2, m);
                }
            return;
        }
        const float sc = (reg == 0) ? SCALE_A : (reg == 3 ? SCALE_B : 1.f);
#pragma unroll
        for (int ai = 0; ai < 2; ++ai)
#pragma unroll
            for (int m = 0; m < 4; ++m) {
#pragma unroll
                for (int bj = 0; bj < 2; ++bj) {
                    const f32x4 v0 = acc[ai][bj][m][0] * (sc * (1.f / KREP)), v1 = acc[ai][bj][m][1] * (sc * (1.f / KREP));
                    u32x4 w; w.x = pk2(v0[0], v0[1]); w.y = pk2(v0[2], v0[3]); w.z = pk2(v1[0], v1[1]); w.w = pk2(v1[2], v1[3]);
                    EPI_ST(at(tb, lo + (unsigned)(bj * HALF) * 2u), w);
                }
                EPI_STEP(lo, INW * 2, m);
            }
    }
};

template <bool ADD> struct EpiGate {
    static constexpr bool PERM = true, AFTER_DRAIN = false; static constexpr int KREP = 1, EREP = 1;
    bf16_t* MG; const bf16_t* G; int gcol;
    __device__ __forceinline__ void operator()(const f32x4 (&acc)[2][2][4][2], const Unit& u, int wr, int wc, int fr, int fq) const {
        const int rl0 = wr * 64 + fr, cl0 = wc * 32 + 8 * fq;
        bf16_t* mb = MG + (size_t)u.pm * BM * D + (size_t)u.pn * BM;
        const bf16_t* gb = G + (size_t)u.pm * BM * INW + gcol + (size_t)u.pn * BM;
        unsigned mo = (unsigned)(rl0 * D + cl0) * 2u, go = (unsigned)(rl0 * INW + cl0) * 2u; asm volatile("" : "+v"(mo), "+v"(go));
#pragma unroll
        for (int ai = 0; ai < 2; ++ai)
#pragma unroll
            for (int mh = 0; mh < 2; ++mh) {
                u32x4 g[2][2], o[2][2];
#pragma unroll
                for (int m = 0; m < 2; ++m)
#pragma unroll
                    for (int bj = 0; bj < 2; ++bj) { g[m][bj] = *(const GAS u32x4*)at(gb, go + (unsigned)(m * 16 * INW + bj * HALF) * 2u);
                        if (ADD) o[m][bj] = *(const GAS u32x4*)at(mb, mo + (unsigned)(m * 16 * D + bj * HALF) * 2u); }
#pragma unroll
                for (int m = 0; m < 2; ++m)
#pragma unroll
                    for (int bj = 0; bj < 2; ++bj) {
                        const f32x4 a0 = acc[ai][bj][2 * mh + m][0], a1 = acc[ai][bj][2 * mh + m][1]; const u32x4 gg = g[m][bj];
                        float r0 = a0[0] * bflo(gg.x), r1 = a0[1] * bfhi(gg.x), r2 = a0[2] * bflo(gg.y), r3 = a0[3] * bfhi(gg.y);
                        float r4 = a1[0] * bflo(gg.z), r5 = a1[1] * bfhi(gg.z), r6 = a1[2] * bflo(gg.w), r7 = a1[3] * bfhi(gg.w);
                        if (ADD) { const u32x4 oo = o[m][bj];
                            r0 += bflo(oo.x); r1 += bfhi(oo.x); r2 += bflo(oo.y); r3 += bfhi(oo.y); r4 += bflo(oo.z); r5 += bfhi(oo.z); r6 += bflo(oo.w); r7 += bfhi(oo.w); }
                        u32x4 w; w.x = pk2(r0, r1); w.y = pk2(r2, r3); w.z = pk2(r4, r5); w.w = pk2(r6, r7);
                        *(GAS u32x4*)at(mb, mo + (unsigned)(m * 16 * D + bj * HALF) * 2u) = w;
                    }
                asm volatile("" ::: "memory");
                go += (unsigned)((mh == 1 ? HALF - 32 : 32) * INW * 2); mo += (unsigned)((mh == 1 ? HALF - 32 : 32) * D * 2); asm volatile("" : "+v"(go), "+v"(mo));
            }
    }
};

struct EpiRes {
    static constexpr bool PERM = true, AFTER_DRAIN = false; static constexpr int KREP = PG8_KREP_RES, EREP = PG8_EREP_RES;
    const float* xp; const float* xs; const float* gate; bf16_t* pre; float* slab;
    const float* xstat; const float* xg; const float* xbias;
    __device__ __forceinline__ void operator()(const f32x4 (&acc)[2][2][4][2], const Unit& u, int wr, int wc, int fr, int fq) const {
        const int rl0 = wr * 64 + fr, cl0 = wc * 32 + 8 * fq;
        const bool samp = u.pm >= MP / BM;
        const float* xb = (samp ? xs + (size_t)(u.pm - MP / BM) * BM * D : xp + (size_t)u.pm * BM * D) + (size_t)u.pn * BM;
        const float* gbase = gate + (size_t)(samp ? NBP + 8 * (u.pm - MP / BM) : (u.pm >> 4)) * MODW + (size_t)u.pn * BM;
        unsigned xo = (unsigned)(rl0 * D + cl0) * 4u, gl = (unsigned)cl0 * 4u; asm volatile("" : "+v"(xo), "+v"(gl));
        if (!samp) {
            bf16_t* pb = pre + (size_t)u.pm * BM * D + (size_t)u.pn * BM;
            f32x4 g[2][2];
#pragma unroll
            for (int bj = 0; bj < 2; ++bj)
#pragma unroll
                for (int n = 0; n < 2; ++n) g[bj][n] = *(const GAS f32x4*)at(gbase, gl + (unsigned)(bj * HALF + n * 4) * 4u);
            if (xstat) {
                const float* st = xstat + (size_t)u.pm * BM * 2;
#pragma unroll
                for (int bj = 0; bj < 2; ++bj) {
                    f32x4 ga[2], ba[2];
#pragma unroll
                    for (int n = 0; n < 2; ++n) { ga[n] = *(const GAS f32x4*)at(xg + (size_t)u.pn * BM, gl + (unsigned)(bj * HALF + n * 4) * 4u) * ALPHA; ba[n] = *(const GAS f32x4*)at(xbias + (size_t)u.pn * BM, gl + (unsigned)(bj * HALF + n * 4) * 4u) * ALPHA; }
                    unsigned so = (unsigned)rl0 * 8u, po = (xo >> 1) + (unsigned)(bj * HALF) * 2u; asm volatile("" : "+v"(so), "+v"(po));
#pragma unroll
                    for (int ai = 0; ai < 2; ++ai) {
                        u32x4 pr[4]; f32x2v ms[4];
#pragma unroll
                        for (int m = 0; m < 4; ++m) { ms[m] = *(const GAS f32x2v*)at(st, so + (unsigned)(m * 16) * 8u); pr[m] = *(const GAS u32x4*)at(pb, po + (unsigned)(m * 16 * D) * 2u); }
#pragma unroll
                        for (int m = 0; m < 4; ++m) {
                            const f32x4 p0 = {bflo(pr[m].x), bfhi(pr[m].x), bflo(pr[m].y), bfhi(pr[m].y)}, p1 = {bflo(pr[m].z), bfhi(pr[m].z), bflo(pr[m].w), bfhi(pr[m].w)};
                            const f32x4 v0 = (p0 - ms[m][0]) * ms[m][1] * ga[0] + ba[0] + g[bj][0] * (acc[ai][bj][m][0] * (1.f / KREP));
                            const f32x4 v1 = (p1 - ms[m][0]) * ms[m][1] * ga[1] + ba[1] + g[bj][1] * (acc[ai][bj][m][1] * (1.f / KREP));
                            u32x4 w; w.x = pk2(v0[0], v0[1]); w.y = pk2(v0[2], v0[3]); w.z = pk2(v1[0], v1[1]); w.w = pk2(v1[2], v1[3]);
                            *(GAS u32x4*)at(pb, po + (unsigned)(m * 16 * D) * 2u) = w;
                        }
                        asm volatile("" ::: "memory");
                        po += (unsigned)(HALF * D * 2); so += (unsigned)(HALF * 8); asm volatile("" : "+v"(po), "+v"(so));
                    }
                }
                return;
            }
#pragma unroll
            for (int bj = 0; bj < 2; ++bj) {
                unsigned xq = xo + (unsigned)(bj * HALF) * 4u; asm volatile("" : "+v"(xq));
#pragma unroll
                for (int ai = 0; ai < 2; ++ai) {
                    f32x4 x[4][2];
#pragma unroll
                    for (int m = 0; m < 4; ++m)
#pragma unroll
                        for (int n = 0; n < 2; ++n) x[m][n] = *(const GAS f32x4*)at(xb, xq + (unsigned)(m * 16 * D + n * 4) * 4u);
#pragma unroll
                    for (int m = 0; m < 4; ++m) {
                        const f32x4 v0 = x[m][0] * ALPHA + g[bj][0] * (acc[ai][bj][m][0] * (1.f / KREP)), v1 = x[m][1] * ALPHA + g[bj][1] * (acc[ai][bj][m][1] * (1.f / KREP));
                        u32x4 w; w.x = pk2(v0[0], v0[1]); w.y = pk2(v0[2], v0[3]); w.z = pk2(v1[0], v1[1]); w.w = pk2(v1[2], v1[3]);
                        *(GAS u32x4*)at(pb, (xq >> 1) + (unsigned)(m * 16 * D) * 2u) = w;
                    }
                    asm volatile("" ::: "memory");
                    xq += (unsigned)(HALF * D * 4); asm volatile("" : "+v"(xq));
                }
            }
            return;
        }
        float* sb = slab + ((size_t)(u.part > 0 ? u.part - 1 : 0) * MS + (size_t)(u.pm - MP / BM) * BM) * D + (size_t)u.pn * BM;
#pragma unroll
        for (int ai = 0; ai < 2; ++ai)
#pragma unroll
            for (int m = 0; m < 4; ++m) {
                const unsigned go = gl + (unsigned)((rl0 + ai * HALF + m * 16) >> 5) * (unsigned)(MODW * 4);
#pragma unroll
                for (int bj = 0; bj < 2; ++bj)
#pragma unroll
                    for (int n = 0; n < 2; ++n) {
                        const unsigned co = (unsigned)(bj * HALF + n * 4) * 4u, ro = (unsigned)((ai * HALF + m * 16) * D) * 4u;
                        const f32x4 g = *(const GAS f32x4*)at(gbase, go + co);
                        f32x4 v = g * (acc[ai][bj][m][n] * (1.f / KREP));
                        if (u.part <= 1) v = v + *(const GAS f32x4*)at(xb, xo + ro + co) * ALPHA;
                        *(GAS f32x4*)at(sb, xo + ro + co) = v;
                    }
            }
    }
};

struct EpiSwiGLU {
    static constexpr bool PERM = true, AFTER_DRAIN = false; static constexpr int KREP = 1, EREP = PG8_EREP_SW;
    bf16_t* HID;
    __device__ __forceinline__ void operator()(const f32x4 (&acc)[2][2][4][2], const Unit& u, int wr, int wc, int fr, int fq) const {
        const int rl0 = wr * 64 + fr, cl0 = wc * 32 + 8 * fq;
        bf16_t* hb = HID + (size_t)u.pm * BM * FF + (size_t)u.pn * HALF;
        unsigned ho = (unsigned)(rl0 * FF + cl0) * 2u; asm volatile("" : "+v"(ho));
#pragma unroll
        for (int ai = 0; ai < 2; ++ai)
#pragma unroll
            for (int m = 0; m < 4; ++m) {
                float r[8];
#pragma unroll
                for (int n = 0; n < 2; ++n)
#pragma unroll
                    for (int e = 0; e < 4; ++e) { const float a = acc[ai][0][m][n][e], b = acc[ai][1][m][n][e]; r[4 * n + e] = a * sigm(a) * b; }
                u32x4 w; w.x = pk2(r[0], r[1]); w.y = pk2(r[2], r[3]); w.z = pk2(r[4], r[5]); w.w = pk2(r[6], r[7]);
                EPI_ST(at(hb, ho), w);
                EPI_STEP(ho, FF * 2, m);
            }
    }
};

template <class Epi, class Sched, bool ALIGN_EPI = false, bool SP2 = false>
__device__ __forceinline__ void gemm_phase(PG8_LAS unsigned char* lds, const Gemm g, const Sched& S, const Epi& E, const unsigned unit_ticks = 0u  ) {
    int tid_ = threadIdx.x; asm volatile("" : "+v"(tid_));
    const int tid = tid_, wid = __builtin_amdgcn_readfirstlane(tid >> 6), lane = tid & 63, wr = wid >> 2, wc = wid & 3, fr = lane & 15, fq = lane >> 4;
    const int K = g.K;
    unsigned voffA[2], voffB[2];
#pragma unroll
    for (int i = 0; i < 2; ++i) { int R, C; stage_rc(tid * 16 + i * 8192, R, C); const int Rb = Epi::PERM ? ((R & ~31) + perm32(R & 31)) : R;
        voffA[i] = (unsigned)(R * K + C) * 2u; voffB[i] = (unsigned)(Rb * K + C) * 2u; }
    const size_t kstep = (size_t)(BK * 2);
    const size_t hstep = (size_t)HALF * K * 2;
    const size_t tstep = 2 * hstep;
    const unsigned ldsw = (unsigned)wid * 1024u;
    const int aoff = lds_byte(wr * 64 + fr, fq * 8), boff = lds_byte(wc * 32 + fr, fq * 8);
#define PG8_SA(b, h) (((b) * 2 + (h)) * HTB)
#define PG8_SB(b, h) ((4 + (b) * 2 + (h)) * HTB)
#define PG8_STAGE(bufoff, gbase, voff) do { _Pragma("unroll") for (int _i = 0; _i < 2; ++_i) \
        __builtin_amdgcn_global_load_lds((const unsigned*)((const char*)(gbase) + (voff)[_i]), (PG8_LAS unsigned*)(lds + (bufoff) + ldsw + _i * 8192), 16, 0, 0); } while (0)
#define PG8_LDA(dst, b, h) do { _Pragma("unroll") for (int m = 0; m < 4; ++m) _Pragma("unroll") for (int k = 0; k < 2; ++k) dst[m][k] = *(const PG8_LAS bf16x8*)(lds + PG8_SA(b, h) + aoff + m * 2048 + k * 1024); } while (0)
#define PG8_LDB(dst, b, h) do { _Pragma("unroll") for (int n = 0; n < 2; ++n) _Pragma("unroll") for (int k = 0; k < 2; ++k) dst[n][k] = *(const PG8_LAS bf16x8*)(lds + PG8_SB(b, h) + boff + n * 2048 + k * 1024); } while (0)
#define PG8_MMA(ai, bj, At, Bt) do { __builtin_amdgcn_s_setprio(1); _Pragma("unroll") for (int m = 0; m < 4; ++m) _Pragma("unroll") for (int n = 0; n < 2; ++n) _Pragma("unroll") for (int k = 0; k < 2; ++k) \
        acc[ai][bj][m][n] = __builtin_amdgcn_mfma_f32_16x16x32_bf16(Bt[n][k], At[m][k], acc[ai][bj][m][n], 0, 0, 0); __builtin_amdgcn_s_setprio(0); } while (0)
#define PG8_WAIT_V(n) asm volatile("s_waitcnt vmcnt(" #n ")" ::: "memory")
#define PG8_WAIT_L(n) asm volatile("s_waitcnt lgkmcnt(" #n ")" ::: "memory")
#define PG8_BAR __builtin_amdgcn_s_barrier()
#define PG8_SCHED __builtin_amdgcn_sched_barrier(0)
    Unit cur, nxt; int ui = 0;
    if (!S.next(0, cur)) return;
    if (unit_ticks) {
        const int gq = (S.c >> 3) & 7; const bool shortwg = S.count() < S.count0();
        const unsigned long long dly = shortwg ? (unsigned long long)(unit_ticks / 8u) * (unsigned)gq : (unsigned long long)(unit_ticks / 16u) * (unsigned)(gq & 3);
        const unsigned long long t0 = __builtin_amdgcn_s_memrealtime();
        while (__builtin_amdgcn_s_memrealtime() - t0 < dly) __builtin_amdgcn_s_sleep(16);
    }
    f32x4 acc[2][2][4][2];
#pragma unroll
    for (int a = 0; a < 2; ++a)
#pragma unroll
        for (int b = 0; b < 2; ++b)
#pragma unroll
            for (int m = 0; m < 4; ++m)
#pragma unroll
                for (int n = 0; n < 2; ++n) acc[a][b][m][n] = (f32x4){0.f, 0.f, 0.f, 0.f};
    bf16x8 At[4][2], B0[2][2], B1[2][2];
    const char* cA = (const char*)g.A + (size_t)cur.pm * tstep + (size_t)cur.kt0 * kstep; const char* cB = (const char*)g.Bt + (size_t)cur.pn * tstep + (size_t)cur.kt0 * kstep;
    int nt = cur.nkt;
    S.a_ready(cur);
    if constexpr (SP2) {
        PG8_STAGE(PG8_SB(0, 0), cB, voffB); PG8_STAGE(PG8_SB(0, 1), cB + hstep, voffB); PG8_STAGE(PG8_SA(0, 0), cA, voffA); PG8_STAGE(PG8_SA(0, 1), cA + hstep, voffA);
        if (wr == 1) PG8_BAR;
        PG8_WAIT_V(2); PG8_BAR;
        PG8_STAGE(PG8_SB(1, 0), cB + kstep, voffB); PG8_STAGE(PG8_SA(1, 0), cA + kstep, voffA); PG8_STAGE(PG8_SB(1, 1), cB + hstep + kstep, voffB);
        PG8_WAIT_V(6); PG8_BAR;
    } else {
        PG8_STAGE(PG8_SB(0, 0), cB, voffB); PG8_STAGE(PG8_SA(0, 0), cA, voffA); PG8_STAGE(PG8_SB(0, 1), cB + hstep, voffB); PG8_STAGE(PG8_SA(0, 1), cA + hstep, voffA);
        if (wr == 1) PG8_BAR;
        PG8_WAIT_V(4); PG8_BAR;
        PG8_STAGE(PG8_SB(1, 0), cB + kstep, voffB); PG8_STAGE(PG8_SA(1, 0), cA + kstep, voffA); PG8_STAGE(PG8_SB(1, 1), cB + hstep + kstep, voffB);
        PG8_WAIT_V(6); PG8_BAR;
    }
    for (;;) {
        const bool has_next = S.next(ui + 1, nxt);
        const char* nA = has_next ? (const char*)g.A + (size_t)nxt.pm * tstep + (size_t)nxt.kt0 * kstep : cA; const char* nB = has_next ? (const char*)g.Bt + (size_t)nxt.pn * tstep + (size_t)nxt.kt0 * kstep : cB;
#ifndef PG8_KREP
#define PG8_KREP 1
#endif
        for (int t2 = 0; t2 < Epi::KREP * nt; t2 += 2) {
            const int t = Epi::KREP == 1 ? t2 : t2 % nt;
            const bool last = (t2 == Epi::KREP * nt - 2);
            const char* a1 = cA + (size_t)(t + 1) * kstep;
            const int t2n = Epi::KREP == 1 ? t + 2 : (t + 2) % nt;
            const char* a2 = last ? nA : cA + (size_t)t2n * kstep; const char* b2 = last ? nB : cB + (size_t)t2n * kstep;
            const char* a3 = a2 + kstep; const char* b3 = b2 + kstep;
            if (last && has_next) S.a_ready(nxt);
            if constexpr (SP2) {
            PG8_LDB(B0, 0, 0); PG8_LDB(B1, 0, 1); PG8_SCHED; PG8_LDA(At, 0, 0); PG8_STAGE(PG8_SA(1, 1), a1 + hstep, voffA);
            PG8_WAIT_V(8); PG8_WAIT_L(0); PG8_BAR; PG8_MMA(0, 0, At, B0); PG8_MMA(0, 1, At, B1); PG8_BAR; PG8_SCHED;
            PG8_LDA(At, 0, 1); PG8_STAGE(PG8_SB(0, 0), b2, voffB); PG8_STAGE(PG8_SB(0, 1), b2 + hstep, voffB); PG8_STAGE(PG8_SA(0, 0), a2, voffA);
            PG8_WAIT_V(8); PG8_WAIT_L(0); PG8_BAR; PG8_MMA(1, 0, At, B0); PG8_MMA(1, 1, At, B1); PG8_BAR; PG8_SCHED;
            PG8_LDB(B0, 1, 0); PG8_LDB(B1, 1, 1); PG8_SCHED; PG8_LDA(At, 1, 0); PG8_STAGE(PG8_SA(0, 1), a2 + hstep, voffA);
            PG8_WAIT_V(8); PG8_WAIT_L(0); PG8_BAR; PG8_MMA(0, 0, At, B0); PG8_MMA(0, 1, At, B1); PG8_BAR; PG8_SCHED;
            PG8_LDA(At, 1, 1); PG8_STAGE(PG8_SB(1, 0), b3, voffB); PG8_STAGE(PG8_SB(1, 1), b3 + hstep, voffB); PG8_STAGE(PG8_SA(1, 0), a3, voffA);
            PG8_WAIT_V(8); PG8_WAIT_L(0); PG8_BAR; PG8_MMA(1, 0, At, B0); PG8_MMA(1, 1, At, B1); PG8_BAR; PG8_SCHED;
            } else {
            PG8_LDB(B0, 0, 0); PG8_SCHED; PG8_LDA(At, 0, 0); PG8_STAGE(PG8_SA(1, 1), a1 + hstep, voffA);
            PG8_WAIT_L(8); PG8_BAR; PG8_WAIT_L(0); PG8_MMA(0, 0, At, B0); PG8_BAR; PG8_SCHED;
            PG8_LDB(B1, 0, 1); PG8_STAGE(PG8_SB(0, 0), b2, voffB);
            PG8_BAR; PG8_WAIT_L(0); PG8_MMA(0, 1, At, B1); PG8_BAR;
            PG8_LDA(At, 0, 1); PG8_STAGE(PG8_SA(0, 0), a2, voffA);
            PG8_BAR; PG8_WAIT_L(0); PG8_MMA(1, 0, At, B0); PG8_BAR; PG8_SCHED;
            PG8_STAGE(PG8_SB(0, 1), b2 + hstep, voffB);
            PG8_WAIT_V(6); PG8_BAR; PG8_MMA(1, 1, At, B1); PG8_BAR;
            PG8_LDB(B0, 1, 0); PG8_SCHED; PG8_LDA(At, 1, 0); PG8_STAGE(PG8_SA(0, 1), a2 + hstep, voffA);
            PG8_WAIT_L(8); PG8_BAR; PG8_WAIT_L(0); PG8_MMA(0, 0, At, B0); PG8_BAR; PG8_SCHED;
            PG8_LDB(B1, 1, 1); PG8_STAGE(PG8_SB(1, 0), b3, voffB);
            PG8_BAR; PG8_WAIT_L(0); PG8_MMA(0, 1, At, B1); PG8_BAR;
            PG8_LDA(At, 1, 1); PG8_STAGE(PG8_SA(1, 0), a3, voffA);
            PG8_BAR; PG8_WAIT_L(0); PG8_MMA(1, 0, At, B0); PG8_BAR; PG8_SCHED;
            PG8_STAGE(PG8_SB(1, 1), b3 + hstep, voffB);
            PG8_WAIT_V(6); PG8_BAR; PG8_MMA(1, 1, At, B1); PG8_BAR;
            }
        }
        if constexpr (ALIGN_EPI) { if (wr == 0) PG8_BAR; }
        if constexpr (!Epi::AFTER_DRAIN) { E(acc, cur, wr, wc, fr, fq); if constexpr (Epi::EREP > 1) { asm volatile("" ::: "memory"); E(acc, cur, wr, wc, fr, fq); } S.done(cur); }
        if (!has_next) break;
#pragma unroll
        for (int a = 0; a < 2; ++a)
#pragma unroll
            for (int b = 0; b < 2; ++b)
#pragma unroll
                for (int m = 0; m < 4; ++m)
#pragma unroll
                    for (int n = 0; n < 2; ++n) acc[a][b][m][n] = (f32x4){0.f, 0.f, 0.f, 0.f};
        cur = nxt; cA = nA; cB = nB; nt = cur.nkt; ++ui;
        if constexpr (ALIGN_EPI) { if (wr == 1) PG8_BAR; }
    }
    PG8_WAIT_V(0);
    if constexpr (!ALIGN_EPI) { if (wr == 0) PG8_BAR; }
    PG8_BAR;
    if constexpr (Epi::AFTER_DRAIN) { E.fused(acc, cur, wr, wc, fr, fq, lds, wid, lane); S.done(cur); }
#undef PG8_SA
#undef PG8_SB
#undef PG8_STAGE
#undef PG8_LDA
#undef PG8_LDB
#undef PG8_MMA
#undef PG8_WAIT_V
#undef PG8_WAIT_L
#undef PG8_BAR
#undef PG8_SCHED
}
}

namespace att {
constexpr int NSLOT = 3, L_K = 0, L_V = 49152, L_TAB = 98304, L_XCH = 0;
__device__ __forceinline__ unsigned off_b(unsigned row, unsigned ch) { return 256u * row + 16u * (ch ^ (((row & 3u) << 2) | ((row >> 2) & 3u))); }
#define MFMA32(a, b, c) __builtin_amdgcn_mfma_f32_32x32x16_bf16((a), (b), (c), 0, 0, 0)
__device__ __forceinline__ void glds16(const void* gsrc, unsigned lds_dst) { unsigned keep;
    asm volatile("s_mov_b32 %0, m0\n\ts_mov_b32 m0, %2\n\ts_nop 0\n\tglobal_load_lds_dwordx4 %1, off\n\ts_mov_b32 m0, %0" : "=&s"(keep) : "v"(gsrc), "s"(lds_dst) : "memory"); }
__device__ __forceinline__ s16x4 vtr(const LAS unsigned char* p) { return __builtin_bit_cast(s16x4, __builtin_amdgcn_ds_read_tr16_b64_v4i16((LAS s16x4*)p)); }

struct Ctx {
    const bf16* QKVG;
    const float *cak, *cav, *cbk, *cbv;
    bf16 *OA, *OB;
    const float* subln;
    float lam, osc;
};

__device__ __forceinline__ void build_tables(LAS unsigned char* lds, const float* t5, const float* relb  ) {
    LAS float* tab = (LAS float*)(lds + L_TAB);
    int tid_ = threadIdx.x; asm volatile("" : "+v"(tid_));
#pragma unroll 1
    for (int e = tid_; e < 2 * 8 * 256; e += NTHREADS) {
        const int mode = e >> 11, hh = (e >> 8) & 7, idx = e & 255, rel = idx - 191;
        float v;
        if (mode == 0) {
            const int n = rel < 0 ? -rel : rel;
            int bk = n < 8 ? n : (n < 12 ? 8 : n < 16 ? 9 : n < 23 ? 10 : n < 32 ? 11 : n < 46 ? 12 : n < 64 ? 13 : n < 91 ? 14 : 15);
            if (rel > 0) bk += 16;
            v = t5[bk * 8 + hh];
        } else {
            int rb = rel < -128 ? -128 : (rel > 128 ? 128 : rel);
            v = relb[(rb + 128) * 8 + hh];
        }
        tab[e] = v * LOG2E;
    }
    __syncthreads();
}

template <int MODE, bool SAMPLE>
__device__ __forceinline__ void unit(LAS unsigned char* lds, const Ctx& C, const int b, const int hh, const int u) {
    constexpr int DK = MODE == 0 ? 64 : 128, NS = DK / 16;
    int tid_ = threadIdx.x; asm volatile("" : "+v"(tid_));
    const int tid = tid_, lane = tid & 63, wid = __builtin_amdgcn_readfirstlane(tid >> 6);
    const int r = lane & 31, h = lane >> 5;
    int t = 0, cw, p_lo, p_hi, wp_lo = 0, qrow0, qpos0; bool has = true;
    if (MODE == 0 && !SAMPLE) { t = wid & 1; const int sub = wid >> 1; qpos0 = 128 * u + 32 * sub; qrow0 = b * SEQ + qpos0; cw = 2 * u + (sub >> 1); p_lo = 0; p_hi = 2 * u + 1; }
    if (MODE == 1 && !SAMPLE) { qpos0 = 256 * u + 32 * wid; qrow0 = b * SEQ + qpos0; cw = 4 * u + (wid >> 1); p_lo = 4 * u - 8 < 0 ? 0 : 4 * u - 8; p_hi = 4 * u + 3; wp_lo = cw - 8; }
    if (MODE == 0 && SAMPLE) { t = wid & 1; has = (wid >> 1) == 0; qpos0 = PAST; qrow0 = MP + b * TS; cw = 16; p_lo = 0; p_hi = 16; }
    if (MODE == 1 && SAMPLE) { has = wid == 0; qpos0 = PAST; qrow0 = MP + b * TS; cw = 16; p_lo = 8; p_hi = 16; wp_lo = 8; }
    const LAS float* tab = (const LAS float*)(lds + L_TAB) + (MODE * 8 + hh) * 256;
    const float cfar = tab[0];
    bf16x8 qf[NS];
    {
        const bf16* qp = C.QKVG + (size_t)(qrow0 + r) * INW + (MODE == 0 ? C_QA + hh * 128 + t * 64 : C_QB + hh * 128) + 8 * h;
#pragma unroll
        for (int s = 0; s < NS; ++s) qf[s] = has ? *(const GAS bf16x8*)(qp + 16 * s) : (bf16x8){0, 0, 0, 0, 0, 0, 0, 0};
    }
    constexpr float THR = 8.f;
    float mref = 0.f, lsum = 0.f;
    f32x16 iniF;
#pragma unroll
    for (int i = 0; i < 16; ++i) iniF[i] = cfar;
    bool first = true;
    f32x16 o[4];
#pragma unroll
    for (int c = 0; c < 4; ++c)
#pragma unroll
        for (int i = 0; i < 16; ++i) o[c][i] = 0.f;
    const unsigned xk = ((unsigned)(r & 3) << 2) | ((unsigned)(r >> 2) & 3u);
    const int q4 = (lane & 15) >> 2, p4 = lane & 3, blk = (lane >> 4) & 1;
    unsigned vbase[2][4];
#pragma unroll
    for (int tt = 0; tt < 2; ++tt)
#pragma unroll
        for (int c = 0; c < 4; ++c) {
            const unsigned ch = (unsigned)(4 * c + 2 * blk + (p4 >> 1)), x = ((unsigned)q4 << 2) | ((unsigned)(2 * tt + h) & 3u);
            vbase[tt][c] = 256u * (unsigned)(8 * tt + 4 * h + q4) + 16u * (ch ^ x) + 8u * (unsigned)(p4 & 1);
        }
    const int kcol = (MODE == 0 ? C_KA : C_KB) + hh * 128, vcol = (MODE == 0 ? C_VA : C_VB) + hh * 128;

    const int drow = 4 * wid + (lane >> 4);
    const unsigned dsrc = (unsigned)(drow * INW + 8 * ((lane & 15) ^ ((((lane >> 4) & 3) << 2) | (wid & 3)))) * 2u;
    f32x4 ck0[2], ck1[2], cv0[2], cv1[2];
#define ATT_ISSUE(pp, bb) do { \
        LAS unsigned char* Kd_ = lds + L_K + (bb) * 16384 + wid * 1024; LAS unsigned char* Vd_ = lds + L_V + (bb) * 16384 + wid * 1024;     \
        if (SAMPLE && (pp) < 16) { \
            const float* ck_ = (MODE == 0 ? C.cak + ((size_t)b * PAST + 64 * (pp)) * 1024 : C.cbk + ((size_t)b * BPAST + 64 * ((pp) - 8)) * 1024) + hh * 128; \
            const float* cv_ = (MODE == 0 ? C.cav + ((size_t)b * PAST + 64 * (pp)) * 1024 : C.cbv + ((size_t)b * BPAST + 64 * ((pp) - 8)) * 1024) + hh * 128; \
            _Pragma("unroll") for (int i_ = 0; i_ < 2; ++i_) { const int id_ = tid + NTHREADS * i_, row_ = id_ >> 4, ch_ = id_ & 15; \
                ck0[i_] = *(const GAS f32x4*)(ck_ + (size_t)row_ * 1024 + ch_ * 8); ck1[i_] = *(const GAS f32x4*)(ck_ + (size_t)row_ * 1024 + ch_ * 8 + 4); \
                cv0[i_] = *(const GAS f32x4*)(cv_ + (size_t)row_ * 1024 + ch_ * 8); cv1[i_] = *(const GAS f32x4*)(cv_ + (size_t)row_ * 1024 + ch_ * 8 + 4); } \
        } else { \
            const bf16* tb_ = C.QKVG + (SAMPLE ? (size_t)(MP + b * TS) : (size_t)b * SEQ + (size_t)64 * (pp)) * INW; \
            const char* ks_ = (const char*)(tb_ + kcol) + dsrc; const char* vs_ = (const char*)(tb_ + vcol) + dsrc; \
            const unsigned kd_ = (unsigned)__builtin_amdgcn_readfirstlane((int)(unsigned)(uintptr_t)Kd_), vd_ = (unsigned)__builtin_amdgcn_readfirstlane((int)(unsigned)(uintptr_t)Vd_); \
            glds16(ks_, kd_); glds16(vs_, vd_); \
            if (!SAMPLE) { glds16(ks_ + (size_t)32 * INW * 2, kd_ + 8192u); glds16(vs_ + (size_t)32 * INW * 2, vd_ + 8192u); } \
        } } while (0)
#define ATT_FINISH(pp, bb) do { if (SAMPLE && (pp) < 16) { \
        LAS unsigned char* Kt_ = lds + L_K + (bb) * 16384; LAS unsigned char* Vt_ = lds + L_V + (bb) * 16384; \
        _Pragma("unroll") for (int i_ = 0; i_ < 2; ++i_) { const int id_ = tid + NTHREADS * i_, row_ = id_ >> 4, ch_ = id_ & 15; \
            v4u kw_, vw_; kw_.x = pk2(ck0[i_][0], ck0[i_][1]); kw_.y = pk2(ck0[i_][2], ck0[i_][3]); kw_.z = pk2(ck1[i_][0], ck1[i_][1]); kw_.w = pk2(ck1[i_][2], ck1[i_][3]); \
            vw_.x = pk2(cv0[i_][0], cv0[i_][1]); vw_.y = pk2(cv0[i_][2], cv0[i_][3]); vw_.z = pk2(cv1[i_][0], cv1[i_][1]); vw_.w = pk2(cv1[i_][2], cv1[i_][3]); \
            const unsigned off_ = off_b((unsigned)row_, (unsigned)ch_); \
            *(LAS v4u*)(Kt_ + off_) = kw_; *(LAS v4u*)(Vt_ + off_) = vw_; } } } while (0)

    ATT_ISSUE(p_lo, 0); ATT_FINISH(p_lo, 0);
    if (!SAMPLE) {
        asm volatile("s_waitcnt vmcnt(0)" ::: "memory");
#pragma unroll
        for (int s = 0; s < NS; ++s) asm volatile("" : "+v"(qf[s]));
        if (p_lo + 1 <= p_hi) ATT_ISSUE(p_lo + 1, 1);
    }
    int slot = 0;
    for (int p = p_lo; p <= p_hi; ++p) {
        const int slot1 = slot == NSLOT - 1 ? 0 : slot + 1, slot2 = slot1 == NSLOT - 1 ? 0 : slot1 + 1;
        LAS unsigned char* Kt = lds + L_K + slot * 16384;
        LAS unsigned char* Vt = lds + L_V + slot * 16384;
        if (!SAMPLE && p + 1 <= p_hi) asm volatile("s_waitcnt vmcnt(4)" ::: "memory");
        else asm volatile("s_waitcnt vmcnt(0)" ::: "memory");
        asm volatile("s_waitcnt lgkmcnt(0)" ::: "memory"); __builtin_amdgcn_s_barrier(); asm volatile("" ::: "memory");
        if (SAMPLE) { if (p < p_hi) ATT_ISSUE(p + 1, slot1); }
        else if (p + 2 <= p_hi) ATT_ISSUE(p + 2, slot2);
        if (has && p >= wp_lo && p <= cw) {
            const int nkb = (SAMPLE && p == 16) ? 1 : 2;
            const bool nearb = p >= cw - 2;
            constexpr int NPRE = 1;
            bf16x8 vpre[NPRE][4];
#pragma unroll
            for (int s2 = 0; s2 < NPRE; ++s2)
#pragma unroll
                for (int c = 0; c < 4; ++c) if (!SAMPLE) { const s16x4 lo = vtr(Vt + 256 * 16 * s2 + vbase[0][c]), hi = vtr(Vt + 256 * 16 * s2 + vbase[1][c]); vpre[s2][c] = __builtin_shufflevector(lo, hi, 0, 1, 2, 3, 4, 5, 6, 7); }
            f32x16 sx[2];
#pragma unroll
            for (int kb = 0; kb < 2; ++kb) {
                if (kb < nkb) {
#pragma unroll
                    for (int s = 0; s < NS; ++s) {
                        const unsigned ch = (unsigned)(2 * ((MODE == 0 ? 4 * t : 0) + s) + h);
                        const bf16x8 kf = *(const LAS bf16x8*)(Kt + 256u * (unsigned)(32 * kb + r) + 16u * (ch ^ xk));
                        sx[kb] = s == 0 ? MFMA32(kf, qf[0], iniF) : MFMA32(kf, qf[s], sx[kb]);
                    }
                    if (nearb) {
                        const LAS float* tp = tab + (64 * p + 32 * kb + 4 * h - (qpos0 + r) + 191);
#pragma unroll
                        for (int i = 0; i < 16; ++i) sx[kb][i] += tp[(i & 3) + 8 * (i >> 2)] - cfar;
                    }
                } else {
#pragma unroll
                    for (int i = 0; i < 16; ++i) sx[kb][i] = -INFINITY;
                }
            }
            float mx = fmaxf(fmaxf(sx[0][0], sx[0][1]), sx[1][0]);
#pragma unroll
            for (int i = 2; i < 16; i += 2) mx = fmaxf(fmaxf(mx, sx[0][i]), sx[0][i + 1]);
#pragma unroll
            for (int i = 1; i < 15; i += 2) mx = fmaxf(fmaxf(mx, sx[1][i]), sx[1][i + 1]);
            mx = fmaxf(mx, sx[1][15]);
            { const auto rr = __builtin_amdgcn_permlane32_swap(__float_as_uint(mx), __float_as_uint(mx), false, false);
              mx = fmaxf(__uint_as_float(rr[0]), __uint_as_float(rr[1])); }
            if (first || __any(mx > THR)) {
                const float d = first ? mx : fmaxf(mx, 0.f), al = __builtin_amdgcn_exp2f(-d);
                mref += d; lsum *= al;
#pragma unroll
                for (int kb = 0; kb < 2; ++kb)
#pragma unroll
                    for (int i = 0; i < 16; ++i) sx[kb][i] -= d;
                if (!first) {
#pragma unroll
                    for (int c = 0; c < 4; ++c)
#pragma unroll
                        for (int i = 0; i < 16; ++i) o[c][i] *= al;
                }
#pragma unroll
                for (int i = 0; i < 16; ++i) iniF[i] = cfar - mref;
                first = false;
            }
            f32x2v ps2 = {0.f, 0.f};
#pragma unroll
            for (int kb = 0; kb < 2; ++kb)
#pragma unroll
                for (int i = 0; i < 16; i += 2) { const float e0 = __builtin_amdgcn_exp2f(sx[kb][i]), e1 = __builtin_amdgcn_exp2f(sx[kb][i + 1]); sx[kb][i] = e0; sx[kb][i + 1] = e1; ps2 += (f32x2v){e0, e1}; }
            lsum += ps2[0] + ps2[1];
#pragma unroll
            for (int kb = 0; kb < 2; ++kb) {
                if (kb < nkb) {
#pragma unroll
                    for (int s2 = 0; s2 < 2; ++s2) {
                        v4u pw; pw.x = pk2(sx[kb][8 * s2 + 0], sx[kb][8 * s2 + 1]); pw.y = pk2(sx[kb][8 * s2 + 2], sx[kb][8 * s2 + 3]);
                        pw.z = pk2(sx[kb][8 * s2 + 4], sx[kb][8 * s2 + 5]); pw.w = pk2(sx[kb][8 * s2 + 6], sx[kb][8 * s2 + 7]);
                        const bf16x8 pf = __builtin_bit_cast(bf16x8, pw);
                        const LAS unsigned char* vb = Vt + 256 * (32 * kb + 16 * s2);
#pragma unroll
                        for (int c = 0; c < 4; ++c) {
                            bf16x8 vf;
                            if (!SAMPLE && kb == 0 && s2 < NPRE) vf = vpre[s2 < NPRE ? s2 : 0][c];
                            else { const s16x4 lo = vtr(vb + vbase[0][c]), hi = vtr(vb + vbase[1][c]); vf = __builtin_shufflevector(lo, hi, 0, 1, 2, 3, 4, 5, 6, 7); }
#if defined(PROBE_VRD2)
                            if (!SAMPLE && MODE == 0) { const s16x4 lo2 = vtr(vb + vbase[0][c] + 16384), hi2 = vtr(vb + vbase[1][c] + 16384); asm volatile("" :: "v"(lo2), "v"(hi2)); }
#endif
                            o[c] = MFMA32(vf, pf, o[c]);
#if defined(PROBE_PV2)
                            if (!SAMPLE && MODE == 0 && (wid & PROBE_PV2) == 0) { asm volatile("" : "+v"(o[c])); o[c] = MFMA32(vf, pf, o[c]); }
#endif
                        }
                    }
                }
            }
        }
        if (SAMPLE && p < p_hi) ATT_FINISH(p + 1, slot1);
        slot = slot1;
    }
    lsum += __shfl_xor(lsum, 32);
#if defined(PROBE_PV2)
    const float il = has ? ((!SAMPLE && MODE == 0 && (wid & PROBE_PV2) == 0) ? 0.5f : 1.f) / lsum : 0.f;
#else
    const float il = has ? 1.f / lsum : 0.f;
#endif
    if (MODE == 1) {
        if (has) {
            bf16* op = C.OB + (size_t)(qrow0 + r) * 1024 + hh * 128 + 4 * h;
#pragma unroll
            for (int c = 0; c < 4; ++c)
#pragma unroll
                for (int g = 0; g < 4; ++g) {
                    v2u w; w.x = pk2(o[c][4 * g] * il, o[c][4 * g + 1] * il); w.y = pk2(o[c][4 * g + 2] * il, o[c][4 * g + 3] * il);
                    *(GAS v2u*)(op + 32 * c + 8 * g) = w;
                }
        }
        __syncthreads();
    } else {
        const int sub = wid >> 1;
        LAS float* xch = (LAS float*)(lds + L_XCH) + sub * 4096;
        __syncthreads();
        if (has && t == 1) {
#pragma unroll
            for (int c = 0; c < 4; ++c)
#pragma unroll
                for (int i = 0; i < 16; ++i) xch[(32 * c + 8 * (i >> 2) + 4 * h + (i & 3)) * 32 + r] = o[c][i] * il;
        }
        __syncthreads();
        if (has && t == 0) {
            float ss = 0.f;
#pragma unroll
            for (int c = 0; c < 4; ++c)
#pragma unroll
                for (int i = 0; i < 16; ++i) { const float v = o[c][i] * il - C.lam * xch[(32 * c + 8 * (i >> 2) + 4 * h + (i & 3)) * 32 + r]; o[c][i] = v; ss += v * v; }
            ss += __shfl_xor(ss, 32);
            const float rs = C.osc / sqrtf(ss * (1.f / 128.f) + LN_EPS);
            bf16* op = C.OA + (size_t)(qrow0 + r) * 1024 + hh * 128 + 4 * h;
#pragma unroll
            for (int c = 0; c < 4; ++c)
#pragma unroll
                for (int g = 0; g < 4; ++g) {
                    const f32x4 gn = *(const GAS f32x4*)(C.subln + 32 * c + 8 * g + 4 * h);
                    v2u w; w.x = pk2(o[c][4 * g] * rs * gn[0], o[c][4 * g + 1] * rs * gn[1]); w.y = pk2(o[c][4 * g + 2] * rs * gn[2], o[c][4 * g + 3] * rs * gn[3]);
                    *(GAS v2u*)(op + 32 * c + 8 * g) = w;
                }
        }
        __syncthreads();
    }
}


#undef MFMA32
#undef ATT_ISSUE
#undef ATT_FINISH
}

#define XB_TMO      128
#define XB_XCNT(j)  (256  + 64 * (j))
#define XB_XSUB(j)  (1280 + 64 * (j))
#define XB_XGEN(j)  (2304 + 64 * (j))
#define XB_TOP      3328
#define XB_TOPGEN   3392
#define XCD_BAR_WORDS 3456
#define XB_SPIN_CAP (1u << 22)

__device__ __forceinline__ unsigned xb_ld(unsigned* p)              { return __hip_atomic_load(p, __ATOMIC_RELAXED, __HIP_MEMORY_SCOPE_AGENT); }
__device__ __forceinline__ unsigned xb_add(unsigned* p, unsigned v) { return __hip_atomic_fetch_add(p, v, __ATOMIC_RELAXED, __HIP_MEMORY_SCOPE_AGENT); }
__device__ __forceinline__ unsigned xb_xcc_id() { return (unsigned)__builtin_amdgcn_s_getreg((3 << 11) | 20) & 0xFu; }
#define XB_SPIN(cond, bar) do { unsigned _sp = 0; while (cond) { __builtin_amdgcn_s_sleep(1); \
    if ((++_sp & 255u) == 0u) { if (xb_ld(&(bar)[XB_TMO])) break; if (_sp > XB_SPIN_CAP) { atomicAdd(&(bar)[XB_TMO], 1u); break; } } } } while (0)

struct XcdBarrier {
    unsigned* bar; unsigned x;
    volatile LAS unsigned* st;
};

__device__ __forceinline__ XcdBarrier xcd_barrier_post(unsigned* bar, volatile LAS unsigned* st) {
    XcdBarrier b; b.bar = bar; b.x = xb_xcc_id(); b.st = st;
    if (threadIdx.x == 0) (void)xb_add(&bar[XB_XCNT(b.x)], 1u);
    return b;
}
__device__ __forceinline__ void xcd_barrier_complete(unsigned* bar, unsigned x, unsigned& nloc, unsigned& nx) {
    const unsigned G = gridDim.x * gridDim.y * gridDim.z;
    unsigned sum, cnt, mine, sp = 0u;
    for (;;) {
        sum = 0u; cnt = 0u; mine = 0u;
#pragma unroll
        for (unsigned j = 0; j < 16; ++j) { const unsigned c = xb_ld(&bar[XB_XCNT(j)]); sum += c; cnt += (c > 0u) ? 1u : 0u; mine = (j == x) ? c : mine; }
        if (sum == G) break;
        __builtin_amdgcn_s_sleep(1);
        if ((++sp & 255u) == 0u) { if (xb_ld(&bar[XB_TMO])) break; if (sp > XB_SPIN_CAP) { atomicAdd(&bar[XB_TMO], 1u); break; } }
    }
    nloc = mine > 0u ? mine : 1u; nx = cnt > 0u ? cnt : 1u;
}

__device__ __forceinline__ void xcd_barrier(const XcdBarrier& b) {
    asm volatile("s_waitcnt vmcnt(0)" ::: "memory");
    __syncthreads();
    if (threadIdx.x == 0) {
        unsigned* bar = b.bar; unsigned bx = b.x; asm volatile("" : "+s"(bar), "+s"(bx));
        __builtin_amdgcn_s_waitcnt(0);
        unsigned nloc = b.st[0], nx = b.st[1];
        if (nloc == 0u) { xcd_barrier_complete(bar, bx, nloc, nx); b.st[0] = nloc; b.st[1] = nx; }
        const unsigned old = xb_add(&bar[XB_XSUB(bx)], 1u);
        const unsigned gen = old / nloc;
        if (old + 1u == (gen + 1u) * nloc) {
            __builtin_amdgcn_fence(__ATOMIC_RELEASE, "agent");
            asm volatile("s_waitcnt vmcnt(0)" ::: "memory");
            const unsigned og = xb_add(&bar[XB_TOP], 1u);
            const unsigned tg = og / nx;
            if (og + 1u == (tg + 1u) * nx) xb_add(&bar[XB_TOPGEN], 1u);
            else XB_SPIN(xb_ld(&bar[XB_TOPGEN]) == tg, bar);
            __builtin_amdgcn_fence(__ATOMIC_ACQUIRE, "agent");
            xb_add(&bar[XB_XGEN(bx)], 1u);
            asm volatile("s_waitcnt vmcnt(0)" ::: "memory");
        } else {
            XB_SPIN(xb_ld(&bar[XB_XGEN(bx)]) == gen, bar);
            __builtin_amdgcn_fence(__ATOMIC_ACQUIRE, "agent");
            asm volatile("s_waitcnt vmcnt(0)" ::: "memory");
        }
    }
    __syncthreads();
}

#ifndef TAIL_S
#define TAIL_S 8
#endif
constexpr size_t WS_STAT = WS_MISC + 4096;
constexpr size_t WS_PRE = WS_QKVG + 512 * MiB;
constexpr size_t WS_SLAB = WS_QKVG + 448 * MiB;

struct Frame {
    LAS unsigned char* lds;
    volatile LAS unsigned* MISC;
    int tid, lane, wave, vcu, G;
};
struct Args { const float* in[N_IN]; float* out; unsigned char* ws; int ph_lo, ph_hi; };
__device__ __forceinline__ float wave_sum(float v) {
    v += __builtin_bit_cast(float, __builtin_amdgcn_update_dpp(0, __builtin_bit_cast(int, v), 0xB1, 0xF, 0xF, false));
    v += __builtin_bit_cast(float, __builtin_amdgcn_update_dpp(0, __builtin_bit_cast(int, v), 0x4E, 0xF, 0xF, false));
    v += __builtin_bit_cast(float, __builtin_amdgcn_update_dpp(0, __builtin_bit_cast(int, v), 0x141, 0xF, 0xF, false));
    v += __builtin_bit_cast(float, __builtin_amdgcn_update_dpp(0, __builtin_bit_cast(int, v), 0x140, 0xF, 0xF, false));
    const float s0 = __builtin_bit_cast(float, __builtin_amdgcn_readlane(__builtin_bit_cast(int, v), 0)), s1 = __builtin_bit_cast(float, __builtin_amdgcn_readlane(__builtin_bit_cast(int, v), 16));
    const float s2 = __builtin_bit_cast(float, __builtin_amdgcn_readlane(__builtin_bit_cast(int, v), 32)), s3 = __builtin_bit_cast(float, __builtin_amdgcn_readlane(__builtin_bit_cast(int, v), 48));
    return (s0 + s1) + (s2 + s3);
}
__device__ __forceinline__ unsigned char* opq(unsigned char* p) { asm volatile("" : "+s"(p)); return p; }
__device__ __forceinline__ bf16* wcopy(unsigned char* ws, int l, size_t off) { return (bf16*)(opq(ws) + WS_W + (size_t)l * WS_WL + off); }
__device__ __forceinline__ float* modp(unsigned char* ws, int l) { return (float*)(opq(ws) + WS_MOD) + (size_t)l * NSEQ * MODW; }

__device__ __forceinline__ void transpose_item(const float* W, int N, bf16* WT, int K, int k0, int n0, int dst_row0, LAS float* scr, int lane) {
    { f32x4 wv[8]; const int n4 = (lane & 7) * 4;
#pragma unroll
      for (int i = 0; i < 8; ++i) wv[i] = *(const GAS f32x4*)(W + (size_t)(k0 + 8 * i + (lane >> 3)) * N + n0 + n4);
#pragma unroll
      for (int i = 0; i < 8; ++i) { LAS float* d = scr + (8 * i + (lane >> 3)) * 33 + n4; d[0] = wv[i][0]; d[1] = wv[i][1]; d[2] = wv[i][2]; d[3] = wv[i][3]; } }
    LDS_WAIT(); asm volatile("" ::: "memory");
    const int c = lane & 7;
#pragma unroll
    for (int j = 0; j < 4; ++j) { const int n = (lane >> 3) + 8 * j; const LAS float* s = scr + (8 * c) * 33 + n;
        v4u o; o.x = pk2(s[0 * 33], s[1 * 33]); o.y = pk2(s[2 * 33], s[3 * 33]); o.z = pk2(s[4 * 33], s[5 * 33]); o.w = pk2(s[6 * 33], s[7 * 33]);
        *(GAS v4u*)(WT + (size_t)(dst_row0 + n) * K + k0 + 8 * c) = o; }
    LDS_WAIT(); asm volatile("" ::: "memory");
}
__device__ __forceinline__ void p0_weights(Frame& F, const Args& A) {
    LAS float* scr = (LAS float*)(F.lds + RING_OFF + F.wave * 16384);
    const int gw = F.vcu * NWAVES + F.wave, NGW = F.G * NWAVES;
    constexpr int I_IN = 32 * 320, I_OA = 16 * 64, I_OUT = 32 * 64, I_1 = 32 * 176, I_2 = 88 * 64, I_LAYER = I_IN + 2 * I_OA + I_OUT + 2 * I_1 + I_2;
    for (int it = gw; it < DEPTH * I_LAYER; it += NGW) {
        const int l = it / I_LAYER; int r = it % I_LAYER;
        if (r < I_IN) { transpose_item(A.in[I_WIN] + (size_t)l * D * INW, INW, wcopy(A.ws, l, WO_WIN), D, 64 * (r / 320), 32 * (r % 320), 32 * (r % 320), scr, F.lane); continue; } r -= I_IN;
        if (r < I_OA) { transpose_item(A.in[I_WOA] + (size_t)l * 1024 * D, D, wcopy(A.ws, l, WO_WOA), 1024, 64 * (r / 64), 32 * (r % 64), 32 * (r % 64), scr, F.lane); continue; } r -= I_OA;
        if (r < I_OA) { transpose_item(A.in[I_WOB] + (size_t)l * 1024 * D, D, wcopy(A.ws, l, WO_WOB), 1024, 64 * (r / 64), 32 * (r % 64), 32 * (r % 64), scr, F.lane); continue; } r -= I_OA;
        if (r < I_OUT) { transpose_item(A.in[I_WOUT] + (size_t)l * D * D, D, wcopy(A.ws, l, WO_WOUT), D, 64 * (r / 64), 32 * (r % 64), 32 * (r % 64), scr, F.lane); continue; } r -= I_OUT;
        if (r < I_1) { const int n0 = 32 * (r % 176); transpose_item(A.in[I_W1] + (size_t)l * D * FF, FF, wcopy(A.ws, l, WO_W13), D, 64 * (r / 176), n0, 256 * (n0 / 128) + (n0 % 128), scr, F.lane); continue; } r -= I_1;
        if (r < I_1) { const int n0 = 32 * (r % 176); transpose_item(A.in[I_W3] + (size_t)l * D * FF, FF, wcopy(A.ws, l, WO_W13), D, 64 * (r / 176), n0, 256 * (n0 / 128) + 128 + (n0 % 128), scr, F.lane); continue; } r -= I_1;
        transpose_item(A.in[I_W2] + (size_t)l * FF * D, D, wcopy(A.ws, l, WO_W2), FF, 64 * (r / 64), 32 * (r % 64), 32 * (r % 64), scr, F.lane);
    }
}
__device__ __forceinline__ void p0_mod(Frame& F, const Args& A) {
    LAS float* SC = (LAS float*)(F.lds + RING_OFF);
    const int r = F.lane & 31, h = F.lane >> 5;
    for (int it = blockIdx.x; it < DEPTH * (MODW / 32); it += gridDim.x) {
        const int l = it / (MODW / 32), n0 = (it % (MODW / 32)) * 32;
        const GAS float* W = (const GAS float*)(A.in[I_WMOD] + (size_t)l * D * MODW + n0 + r);
        f32x16 acc0, acc1;
#pragma unroll
        for (int i = 0; i < 16; ++i) { acc0[i] = 0.f; acc1[i] = 0.f; }
        for (int kq = 0; kq < 4; ++kq) {
            __syncthreads();
            { const int k = kq * 512 + F.tid;
#pragma unroll
              for (int s = 0; s < NSEQ; ++s) { const float c = ((const GAS float*)(s < NBP ? A.in[I_CP] + (size_t)s * D : A.in[I_CS] + (size_t)(s - NBP) * D))[k]; SC[F.tid * NSEQ + s] = c / (1.f + __expf(-c)); } }
            __syncthreads();
#pragma unroll 8
            for (int i = 0; i < 32; ++i) {
                const int kl = F.wave * 64 + 2 * i + h;
                const float a = W[(size_t)(kq * 512 + kl) * MODW];
                const float b0 = SC[kl * NSEQ + r], b1 = r < NSEQ - 32 ? SC[kl * NSEQ + 32 + r] : 0.f;
                acc0 = __builtin_amdgcn_mfma_f32_32x32x2f32(a, b0, acc0, 0, 0, 0);
                acc1 = __builtin_amdgcn_mfma_f32_32x32x2f32(a, b1, acc1, 0, 0, 0);
            }
        }
        __syncthreads();
        LAS float* RED = SC;
#pragma unroll
        for (int i = 0; i < 16; ++i) { const int n = (i & 3) + 8 * (i >> 2) + 4 * h;
            RED[(F.wave * 32 + n) * NSEQ + r] = acc0[i];
            if (r < NSEQ - 32) RED[(F.wave * 32 + n) * NSEQ + 32 + r] = acc1[i]; }
        __syncthreads();
        for (int o = F.tid; o < NSEQ * 32; o += NTHREADS) { const int s = o >> 5, c2 = o & 31; float v = 0.f;
#pragma unroll
            for (int w = 0; w < NWAVES; ++w) v += RED[(w * 32 + c2) * NSEQ + s];
            modp(A.ws, l)[(size_t)s * MODW + n0 + c2] = v + A.in[I_BMOD][(size_t)l * MODW + n0 + c2]; }
    }
    __syncthreads();
    if (blockIdx.x == 0 && F.tid < DEPTH) {
        const int l = F.tid; float s1 = 0.f, s2 = 0.f;
        for (int i = 0; i < 64; ++i) { s1 += A.in[I_LQ1][l * 64 + i] * A.in[I_LK1][l * 64 + i]; s2 += A.in[I_LQ2][l * 64 + i] * A.in[I_LK2][l * 64 + i]; }
        const float lam_init = 0.8f - 0.6f * expf(-0.3f * (float)l);
        ((float*)(opq(A.ws) + WS_MISC))[l] = expf(s1) - expf(s2) + lam_init;
    }
}
__device__ __forceinline__ void ln_stats(const f32x4 (&v)[8], float& mean, float& rstd) {
    float s = 0.f;
#pragma unroll
    for (int j = 0; j < 8; ++j) s += (v[j][0] + v[j][1]) + (v[j][2] + v[j][3]);
    mean = wave_sum(s) * (1.f / D); float q = 0.f;
#pragma unroll
    for (int j = 0; j < 8; ++j) { const f32x4 d = v[j] - mean; q += (d[0] * d[0] + d[1] * d[1]) + (d[2] * d[2] + d[3] * d[3]); }
    rstd = 1.f / sqrtf(wave_sum(q) * (1.f / D) + LN_EPS);
}
template <int KIND>
__device__ __forceinline__ void ln_row(f32x4 (&v)[8], const int row, const int lane, float* inout, const float* gain, const float* bias, const float* mrow, bf16* H, float* stats = nullptr) {
    f32x4 shv[8], scv[8];
    if (mrow) { const float* mr = mrow + (size_t)row_seq(row) * MODW;
#pragma unroll
        for (int j = 0; j < 8; ++j) { shv[j] = *(const GAS f32x4*)(mr + 4 * lane + 256 * j); scv[j] = *(const GAS f32x4*)(mr + D + 4 * lane + 256 * j); } }
    float mean, rstd;
    ln_stats(v, mean, rstd);
    if (KIND == 1) {
        float* dst = inout + (size_t)row * D;
        const bool keep = !(stats && row < MP);
        if (!keep && lane == 0) *(GAS f32x2v*)(stats + 2 * (size_t)row) = (f32x2v){mean, rstd};
#pragma unroll
        for (int j = 0; j < 8; ++j) { const f32x4 g = *(const GAS f32x4*)(gain + 4 * lane + 256 * j), bb = *(const GAS f32x4*)(bias + 4 * lane + 256 * j);
            v[j] = (v[j] - mean) * rstd * g + bb; if (keep) *(GAS f32x4*)(dst + 4 * lane + 256 * j) = v[j]; }
        if (mrow) ln_stats(v, mean, rstd);
    }
    if (mrow) {
        bf16* hp = H + (size_t)row * D;
#pragma unroll
        for (int j = 0; j < 8; ++j) { const f32x4 o = (v[j] - mean) * rstd * (scv[j] + 1.f) + shv[j];
            v2u w; w.x = pk2(o[0], o[1]); w.y = pk2(o[2], o[3]); *(GAS v2u*)(hp + 4 * lane + 256 * j) = w; }
    }
}
template <int KIND>
__device__ __forceinline__ void ln_phase(Frame& F, const float* xp, const float* xs, float* inout, const float* gain, const float* bias, const float* mrow, bf16* H,
                                         const bf16* pre = nullptr, const float* slab = nullptr, const int nparts = 0, float* stats = nullptr) {
    const int gw = F.vcu * NWAVES + F.wave, NGW = F.G * NWAVES;
    int lane_ = F.lane; asm volatile("" : "+v"(lane_)); const int lane = lane_;
    if (KIND == 0) {
        f32x4 vn[8];
        { const int row = gw; if (row < M) { const float* src = row < MP ? xp + (size_t)row * D : xs + (size_t)(row - MP) * D;
#pragma unroll
            for (int j = 0; j < 8; ++j) vn[j] = *(const GAS f32x4*)(src + 4 * lane + 256 * j); } }
        for (int row = gw; row < M; row += NGW) {
            f32x4 v[8];
#pragma unroll
            for (int j = 0; j < 8; ++j) v[j] = vn[j];
            { const int nrow = row + NGW; if (nrow < M) { const float* src = nrow < MP ? xp + (size_t)nrow * D : xs + (size_t)(nrow - MP) * D;
#pragma unroll
                for (int j = 0; j < 8; ++j) vn[j] = *(const GAS f32x4*)(src + 4 * lane + 256 * j); } }
            ln_row<KIND>(v, row, lane, inout, gain, bias, mrow, H);
        }
    } else {
        v2u vn[8];
        { const int row = gw; if (row < MP) { const bf16* src = pre + (size_t)row * D;
#pragma unroll
            for (int j = 0; j < 8; ++j) vn[j] = *(const GAS v2u*)(src + 4 * lane + 256 * j); } }
        for (int row = MP + gw; row < M; row += NGW) {
            f32x4 v[8];
            const float* s0 = slab + (size_t)(row - MP) * D + 4 * lane;
#pragma unroll
            for (int j = 0; j < 8; ++j) v[j] = (f32x4){0.f, 0.f, 0.f, 0.f};
            int p = 0;
#pragma unroll 1
            for (; p + 4 <= nparts; p += 4) {
                f32x4 t[4][8];
#pragma unroll
                for (int q = 0; q < 4; ++q)
#pragma unroll
                    for (int j = 0; j < 8; ++j) t[q][j] = *(const GAS f32x4*)(s0 + (size_t)(p + q) * MS * D + 256 * j);
#pragma unroll
                for (int j = 0; j < 8; ++j) v[j] = v[j] + ((t[0][j] + t[1][j]) + (t[2][j] + t[3][j]));
            }
#pragma unroll 1
            for (; p < nparts; ++p) {
#pragma unroll
                for (int j = 0; j < 8; ++j) v[j] = v[j] + *(const GAS f32x4*)(s0 + (size_t)p * MS * D + 256 * j);
            }
            ln_row<KIND>(v, row, lane, inout, gain, bias, mrow, H, stats);
        }
        for (int row = gw; row < MP; row += NGW) {
            f32x4 v[8];
#pragma unroll
            for (int j = 0; j < 8; ++j) v[j] = (f32x4){bflo(vn[j].x), bfhi(vn[j].x), bflo(vn[j].y), bfhi(vn[j].y)};
            { const int nrow = row + NGW; if (nrow < MP) { const bf16* src = pre + (size_t)nrow * D;
#pragma unroll
                for (int j = 0; j < 8; ++j) vn[j] = *(const GAS v2u*)(src + 4 * lane + 256 * j); } }
            ln_row<KIND>(v, row, lane, inout, gain, bias, mrow, H, stats);
        }
    }
}

__device__ __forceinline__ void kv_outputs(Frame& F, const bf16* QKVGp, float* out, int l) {
    const int gw = F.vcu * NWAVES + F.wave, NGW = F.G * NWAVES;
    int lane_ = F.lane; asm volatile("" : "+v"(lane_)); const int lane = lane_;
    v4u wn[8];
#define KV_LOAD(dst_, row_) do { const int r_ = (row_); const bool hb_ = r_ >= MP || (r_ & (SEQ - 1)) >= SEQ - 512; const bf16* s_ = QKVGp + (size_t)r_ * INW; \
        _Pragma("unroll") for (int j = 0; j < 8; ++j) if (j < 4 || hb_) dst_[j] = *(const GAS v4u*)(s_ + (j < 2 ? C_KA : j < 4 ? C_VA : j < 6 ? C_KB : C_VB) + (size_t)(8 * (lane + 64 * (j & 1)))); } while (0)
    if (gw < M) KV_LOAD(wn, gw);
    for (int row = gw; row < M; row += NGW) {
        const bool samp = row >= MP; const int t = row & (SEQ - 1);
        const bool hasb = samp || t >= SEQ - 512;
        float* oa = samp ? out + O_AKS + ((size_t)l * MS + (row - MP)) * 1024 : out + O_AKP + ((size_t)l * MP + row) * 1024;
        float* ob = samp ? out + O_BKS + ((size_t)l * MS + (row - MP)) * 1024 : out + O_BKP + ((size_t)(l * NBP + (row >> 12)) * 512 + (t - (SEQ - 512))) * 1024;
        const size_t av_off = samp ? O_AVS - O_AKS : O_AVP - O_AKP, bv_off = samp ? O_BVS - O_BKS : O_BVP - O_BKP;
        v4u w[8];
#pragma unroll
        for (int j = 0; j < 8; ++j) w[j] = wn[j];
        if (row + NGW < M) KV_LOAD(wn, row + NGW);
#pragma unroll
        for (int j = 0; j < 8; ++j) if (j < 4 || hasb) {
            float* dst = (j < 4 ? oa + (j >= 2 ? av_off : 0) : ob + (j >= 6 ? bv_off : 0)) + 8 * (lane + 64 * (j & 1));
            const f32x4 a = {bflo(w[j].x), bfhi(w[j].x), bflo(w[j].y), bfhi(w[j].y)}, b = {bflo(w[j].z), bfhi(w[j].z), bflo(w[j].w), bfhi(w[j].w)};
            __builtin_nontemporal_store(a, (GAS f32x4*)dst); __builtin_nontemporal_store(b, (GAS f32x4*)(dst + 4));
        }
    }
#undef KV_LOAD
}
__device__ __forceinline__ void attn_phase(Frame& F, const Args& A, int l) {
    kv_outputs(F, (const bf16*)(opq(A.ws) + WS_QKVG), (float*)opq((unsigned char*)A.out), l);
    att::build_tables(F.lds + RING_OFF, A.in[I_T5], A.in[I_REL] + (size_t)l * 257 * 8);
    att::Ctx C;
    C.QKVG = (const bf16*)(opq(A.ws) + WS_QKVG);
    C.cak = A.in[I_CAK] + (size_t)l * NBS * PAST * 1024; C.cav = A.in[I_CAV] + (size_t)l * NBS * PAST * 1024;
    C.cbk = A.in[I_CBK] + (size_t)l * NBS * BPAST * 1024; C.cbv = A.in[I_CBV] + (size_t)l * NBS * BPAST * 1024;
    C.OA = (bf16*)(opq(A.ws) + WS_OA); C.OB = (bf16*)(opq(A.ws) + WS_OB);
    C.subln = A.in[I_SUBLN] + l * 128;
    C.lam = ((const float*)(opq(A.ws) + WS_MISC))[l];
    C.osc = 1.f - (0.8f - 0.6f * expf(-0.3f * (float)l));
    LAS unsigned char* lds = F.lds + RING_OFF;
#ifndef PROBE_ATT
#define PROBE_ATT 0
#endif
#ifndef ATT_MASK
#define ATT_MASK 15
#endif
#define ATT_A_LOOP() if (ATT_MASK & 1) for (int pj = F.vcu; pj < 1024; pj += F.G) { const int pi = 1023 - pj, bh = pi >> 4, s = pi & 15;     \
        _Pragma("unroll 1") for (int k = 0; k < 2; ++k) att::unit<0, false>(lds, C, bh >> 3, bh & 7, k == 0 ? 31 - s : s); }
#define ATT_B_LOOP() if (ATT_MASK & 2) for (int bj = F.vcu; bj < 1024; bj += F.G) { const int bi = 1023 - bj, bh = bi >> 4; att::unit<1, false>(lds, C, bh >> 3, bh & 7, bi & 15); }
#define ATT_S_LOOP() do { if (ATT_MASK & 4) for (int si = F.vcu; si < NBS * 8; si += F.G) att::unit<0, true>(lds, C, si >> 3, si & 7, 0); \
        if (ATT_MASK & 8) for (int si = F.vcu; si < NBS * 8; si += F.G) att::unit<1, true>(lds, C, si >> 3, si & 7, 0); } while (0)
    ATT_A_LOOP();
#if PROBE_ATT & 1
    ATT_A_LOOP();
#endif
    ATT_B_LOOP();
#if PROBE_ATT & 2
    ATT_B_LOOP();
#endif
    ATT_S_LOOP();
#if PROBE_ATT & 4
    ATT_S_LOOP();
#endif
#undef ATT_A_LOOP
#undef ATT_B_LOOP
#undef ATT_S_LOOP
}

#ifndef MK_STAGGER
#define MK_STAGGER 0
#endif
#define STAG(t) (MK_STAGGER ? (t) : 0u)
#ifndef PROBE_REP
#define PROBE_REP 0
#endif
#ifndef MK_PER_PHASE
#define MK_PER_PHASE 0
#endif
constexpr int N_PHASES = 2 + 8 * DEPTH;
__global__ void __launch_bounds__(NTHREADS, 2) fwd_kernel(Args args) {
    extern __shared__ __attribute__((aligned(16))) unsigned char lds[];
    Frame F;
    F.lds = (LAS unsigned char*)lds;
    F.MISC = (volatile LAS unsigned*)(F.lds + MISC_OFF);
    F.tid = threadIdx.x; F.lane = F.tid & 63; F.wave = __builtin_amdgcn_readfirstlane(F.tid >> 6);
    F.G = gridDim.x; { const int bx = blockIdx.x; F.vcu = (F.G % 8 == 0) ? (bx % 8) * (F.G / 8) + bx / 8 : bx; }
    for (int u = F.tid; u < (LDS_BYTES - LDSCTL_OFF) / 4; u += NTHREADS) ((LAS unsigned*)(F.lds + LDSCTL_OFF))[u] = 0u;
    __syncthreads();
    XcdBarrier bar; bar.bar = (unsigned*)((gu32*)(opq(args.ws) + WS_CTL) + CW_BAR); bar.x = 0; bar.st = nullptr;
    if (!MK_PER_PHASE) bar = xcd_barrier_post((unsigned*)((gu32*)(opq(args.ws) + WS_CTL) + CW_BAR), F.MISC + 8);
    const int lo = args.ph_lo, hi = args.ph_hi; (void)lo; (void)hi;
#ifndef PH_MASK
#define PH_MASK 0xffffffffu
#endif
#define PHM(j) ((PH_MASK >> (j)) & 1u)
#if MK_PER_PHASE
#define IN(k) (lo <= (k) && (k) < hi)
#else
#define IN(k) true
#endif
#if defined(PROBE_BAR2)
#define SEAM(k) do { if (IN(k) && IN((k) + 1)) { xcd_barrier(bar); xcd_barrier(bar); } } while (0)
#else
#define SEAM(k) do { if (IN(k) && IN((k) + 1)) xcd_barrier(bar); } while (0)
#endif

#define Hb ((bf16*)(opq(args.ws) + WS_H))
#define QKVG ((bf16*)(opq(args.ws) + WS_QKVG))
#define XB ((float*)(opq(args.ws) + WS_XB))
#define Y ((float*)opq((unsigned char*)args.out) + O_YP)
    LAS unsigned char* const ring = F.lds + RING_OFF;
    const int tailS = F.G >= 32 * TAIL_S ? TAIL_S : F.G >= 128 ? 4 : F.G >= 64 ? 2 : 1;

    for (int rep_ = 0; rep_ < (PROBE_REP == 100 ? 2 : 1); ++rep_) { if (PHM(0) && IN(0)) { p0_weights(F, args); __syncthreads(); }
    if (PHM(10) && IN(0)) { p0_mod(F, args); } __syncthreads();
#if PROBE_REP == 102
    p0_mod(F, args); __syncthreads();
#endif
#if PROBE_REP == 103
    p0_weights(F, args); __syncthreads();
#endif
    }
    SEAM(0);
    if (PHM(1) && IN(1)) ln_phase<0>(F, args.in[I_XP], args.in[I_XS], nullptr, nullptr, nullptr, modp(args.ws, 0), Hb);
#if PROBE_REP == 101
    __syncthreads(); ln_phase<0>(F, args.in[I_XP], args.in[I_XS], nullptr, nullptr, nullptr, modp(args.ws, 0), Hb);
    __syncthreads(); ln_phase<0>(F, args.in[I_XP], args.in[I_XS], nullptr, nullptr, nullptr, modp(args.ws, 0), Hb);
#endif
    SEAM(1);
#pragma unroll 1
    for (int l = 0; l < DEPTH; ++l) {
        const int pb = 2 + 8 * l;
        const float* xin_p = l == 0 ? args.in[I_XP] : Y;
        const float* xin_s = l == 0 ? args.in[I_XS] : Y + (size_t)MP * D;
        for (int rep_ = 0; rep_ < (PROBE_REP == 2 ? 2 : 1); ++rep_) if (PHM(2) && IN(pb + 0)) {
            pg8::Gemm g{Hb, wcopy(args.ws, l, WO_WIN), M, INW, D}; pg8::StaticOrder S; S.init(M, INW, F.G, (int)blockIdx.x, D);
            pg8::EpiIn E{QKVG, (float*)opq((unsigned char*)args.out), l};
            pg8::gemm_phase<pg8::EpiIn, pg8::StaticOrder, true, true>(ring, g, S, E, STAG(6000u));
        }
        SEAM(pb + 0);
        if (PHM(3) && IN(pb + 1)) { attn_phase(F, args, l);
#if defined(PROBE_ATTN2)
            __syncthreads(); attn_phase(F, args, l);
#endif
        }
        SEAM(pb + 1);
        for (int rep_ = 0; rep_ < (PROBE_REP == 4 ? 2 : 1); ++rep_) if (PHM(4) && IN(pb + 2)) {
            { pg8::Gemm g{(const bf16*)(opq(args.ws) + WS_OA), wcopy(args.ws, l, WO_WOA), M, D, 1024}; pg8::StaticOrder S; S.init(M, D, F.G, (int)blockIdx.x, 1024);
              pg8::EpiGate<false> E{Hb, QKVG, C_GA};
              pg8::gemm_phase<pg8::EpiGate<false>, pg8::StaticOrder, true, true>(ring, g, S, E, STAG(3400u));
              { const int nwg_ = (M / 256) * (D / 256), whole_ = nwg_ / F.G, T_ = nwg_ - whole_ * F.G;
                if (T_ > 0 && 2 * T_ <= F.G && (int)blockIdx.x < T_ && F.tid == 0) {
                    __builtin_amdgcn_fence(__ATOMIC_RELEASE, "agent"); asm volatile("s_waitcnt vmcnt(0)" ::: "memory");
                    __hip_atomic_store((gu32*)(opq(args.ws) + WS_CTL) + 64 + 64 * l + (int)blockIdx.x, 1u, RLX_AGENT); } } }
            { pg8::Gemm g{(const bf16*)(opq(args.ws) + WS_OB), wcopy(args.ws, l, WO_WOB), M, D, 1024}; pg8::ShiftedTailOrder S; S.init(M, D, F.G, (int)blockIdx.x, 1024, (unsigned*)((gu32*)(opq(args.ws) + WS_CTL) + 64 + 64 * l));
              pg8::EpiGate<true> E{Hb, QKVG, C_GB};
              pg8::gemm_phase<pg8::EpiGate<true>, pg8::ShiftedTailOrder, true, true>(ring, g, S, E, STAG(3400u)); }
        }
        SEAM(pb + 2);
        for (int rep_ = 0; rep_ < (PROBE_REP == 5 ? 2 : 1); ++rep_) if (PHM(5) && IN(pb + 3)) {
            pg8::Gemm g{Hb, wcopy(args.ws, l, WO_WOUT), M, D, D}; pg8::TailOrder S; S.init(D, F.G, (int)blockIdx.x, D, tailS);
            pg8::EpiRes E{xin_p, xin_s, modp(args.ws, l) + 2 * D, (bf16*)(opq(args.ws) + WS_PRE), (float*)(opq(args.ws) + WS_SLAB), nullptr, nullptr, nullptr};
            pg8::gemm_phase<pg8::EpiRes, pg8::TailOrder, true, true>(ring, g, S, E, STAG(6000u));
        }
        SEAM(pb + 3);
        if (PHM(6) && IN(pb + 4)) ln_phase<1>(F, nullptr, nullptr, XB, args.in[I_LN1G] + l * D, args.in[I_LN1B] + l * D, modp(args.ws, l) + 3 * D, Hb, (const bf16*)(opq(args.ws) + WS_PRE), (const float*)(opq(args.ws) + WS_SLAB), tailS, (float*)(opq(args.ws) + WS_STAT));
        SEAM(pb + 4);
        for (int rep_ = 0; rep_ < (PROBE_REP == 7 ? 2 : 1); ++rep_) if (PHM(7) && IN(pb + 5)) {
            pg8::Gemm g{Hb, wcopy(args.ws, l, WO_W13), M, FF2, D}; pg8::StaticOrder S; S.init(M, FF2, F.G, (int)blockIdx.x, D);
            pg8::EpiSwiGLU E{QKVG};
            pg8::gemm_phase<pg8::EpiSwiGLU, pg8::StaticOrder, true, true>(ring, g, S, E, STAG(5000u));
        }
        SEAM(pb + 5);
        for (int rep_ = 0; rep_ < (PROBE_REP == 8 ? 2 : 1); ++rep_) if (PHM(8) && IN(pb + 6)) {
            pg8::Gemm g{QKVG, wcopy(args.ws, l, WO_W2), M, D, FF}; pg8::TailOrder S; S.init(D, F.G, (int)blockIdx.x, FF, tailS, true);
            pg8::EpiRes E{XB, XB + (size_t)MP * D, modp(args.ws, l) + 5 * D, (bf16*)(opq(args.ws) + WS_PRE), (float*)(opq(args.ws) + WS_SLAB), (const float*)(opq(args.ws) + WS_STAT), args.in[I_LN1G] + l * D, args.in[I_LN1B] + l * D};
            pg8::gemm_phase<pg8::EpiRes, pg8::TailOrder, true, true>(ring, g, S, E, STAG(15000u));
        }
        SEAM(pb + 6);
        if (PHM(9) && IN(pb + 7)) ln_phase<1>(F, nullptr, nullptr, Y, args.in[I_LN2G] + l * D, args.in[I_LN2B] + l * D, l + 1 < DEPTH ? modp(args.ws, l + 1) : nullptr, Hb, (const bf16*)(opq(args.ws) + WS_PRE), (const float*)(opq(args.ws) + WS_SLAB), tailS);
        if (l + 1 < DEPTH) SEAM(pb + 7);
    }
#undef IN
#undef SEAM
#undef Hb
#undef QKVG
#undef XB
#undef Y
}

extern "C" void kernel_launch(void* const* d_in, const int* in_sizes, int n_in, void* d_out, int out_size, void* d_ws, size_t ws_size, hipStream_t stream) {
    static int grid = 0;
    if (grid == 0) {
        if (n_in != N_IN || in_sizes[0] != MP * D || (size_t)out_size != O_TOTAL || ws_size < WS_END) {
            fprintf(stderr, "kernel_launch: unexpected problem: n_in %d in0 %d out %d ws %zu (need %zu); nothing launched\n", n_in, n_in > 0 ? in_sizes[0] : -1, out_size, ws_size, (size_t)WS_END); grid = -1; return; }
        int dev = 0, cus = 0, per_cu = 0;
        if (hipGetDevice(&dev) != hipSuccess || hipDeviceGetAttribute(&cus, hipDeviceAttributeMultiprocessorCount, dev) != hipSuccess) { grid = -1; return; }
        if (hipFuncSetAttribute((const void*)fwd_kernel, hipFuncAttributeMaxDynamicSharedMemorySize, LDS_BYTES) != hipSuccess) { fprintf(stderr, "kernel_launch: hipFuncSetAttribute failed\n"); grid = -1; return; }
        if (hipOccupancyMaxActiveBlocksPerMultiprocessor(&per_cu, (const void*)fwd_kernel, NTHREADS, LDS_BYTES) != hipSuccess || per_cu < 1)
            fprintf(stderr, "kernel_launch: note: occupancy query reports %d workgroups per CU\n", per_cu);
        (void)hipGetLastError();
        grid = cus;
    }
    if (grid < 0) return;
    if (hipMemsetAsync((char*)d_ws + WS_CTL, 0, CTL_ZERO_BYTES, stream) != hipSuccess) return;
    Args a{};
    for (int i = 0; i < N_IN; ++i) a.in[i] = (const float*)d_in[i];
    a.out = (float*)d_out; a.ws = (unsigned char*)d_ws;
#if MK_PER_PHASE
    for (int p = 0; p < N_PHASES; ++p) { a.ph_lo = p; a.ph_hi = p + 1; hipLaunchKernelGGL(fwd_kernel, dim3(grid), dim3(NTHREADS), LDS_BYTES, stream, a); }
#else
    a.ph_lo = 0; a.ph_hi = N_PHASES;
    hipLaunchKernelGGL(fwd_kernel, dim3(grid), dim3(NTHREADS), LDS_BYTES, stream, a);
#endif
    const hipError_t le = hipPeekAtLastError();
    if (le != hipSuccess) fprintf(stderr, "kernel_launch: launch failed: %s\n", hipGetErrorName(le));
}
```

```cpp
#include <hip/hip_runtime.h>
#include <hip/hip_bf16.h>
#include <cstdio>
#include <cstdint>
#include <cmath>

constexpr int D = 2048, NBP = 8, SEQ = 4096, NBS = 32, TS = 32, PAST = 1024, BPAST = 512, DEPTH = 2;
constexpr int MP = NBP * SEQ, MS = NBS * TS, M = MP + MS;
constexpr int NSEQ = NBP + NBS;
constexpr int INW = 10240, FF = 5632, FF2 = 2 * FF, MODW = 6 * D;
constexpr int C_QA = 0, C_KA = 1024, C_VA = 2048, C_QB = 3072, C_KB = 4096, C_VB = 5120, C_GA = 6144, C_GB = 8192;
constexpr float LN_EPS = 1e-5f;
constexpr float ALPHA = 1.4142135623730951f;
constexpr float LOG2E = 1.4426950408889634f;
constexpr float SCALE_A = 0.18033688011112042f;
constexpr float SCALE_B = 0.12751743082459868f;
constexpr size_t O_YP = 0, O_YS = 67108864, O_AKP = 69206016, O_AVP = 136314880, O_BKP = 203423744, O_BVP = 211812352,
                 O_AKS = 220200960, O_AVS = 222298112, O_BKS = 224395264, O_BVS = 226492416, O_TOTAL = 228589568;
enum { I_XP = 0, I_XS, I_CAK, I_CAV, I_CBK, I_CBV, I_CP, I_CS, I_WMOD, I_BMOD, I_WIN, I_LQ1, I_LK1, I_LQ2, I_LK2, I_SUBLN, I_T5, I_REL, I_WOA, I_WOB, I_WOUT,
       I_LN1G, I_LN1B, I_W1, I_W3, I_W2, I_LN2G, I_LN2B, N_IN };

constexpr size_t MiB = 1u << 20;
constexpr size_t WS_CTL = 0, CTL_ZERO_BYTES = 32768;
constexpr size_t WS_MISC = 1 * MiB;
constexpr size_t WS_MOD = 2 * MiB;
constexpr size_t WS_W = 8 * MiB, WS_WL = 122 * MiB;
constexpr size_t WO_WIN = 0, WO_WOA = 40 * MiB, WO_WOB = 44 * MiB, WO_WOUT = 48 * MiB, WO_W13 = 56 * MiB, WO_W2 = 100 * MiB;
constexpr size_t WS_XB = 256 * MiB;
constexpr size_t WS_OA = WS_XB, WS_OB = WS_XB + 66 * MiB;
constexpr size_t WS_H = 520 * MiB;
constexpr size_t WS_QKVG = 652 * MiB;
constexpr size_t WS_END = 1312 * MiB;
static_assert(WS_W + 2 * WS_WL <= WS_XB && WS_XB + (size_t)M * D * 4 <= WS_H && WS_H + (size_t)M * D * 2 <= WS_QKVG && WS_QKVG + (size_t)M * INW * 2 <= WS_END, "d_ws map");
static_assert((size_t)M * 1024 * 2 <= 66 * MiB && (size_t)DEPTH * NSEQ * MODW * 4 <= 6 * MiB && (size_t)FF2 * D * 2 <= 44 * MiB && (size_t)D * FF * 2 <= 22 * MiB, "d_ws map 2");
constexpr int CW_TMO = 0, CW_BAR = 4096;
static_assert((CW_BAR + 3456) * 4 <= (int)CTL_ZERO_BYTES, "barrier words inside the per-call memset");

constexpr int RING_OFF = 0, RING_BYTES = 131072;
constexpr int LDSCTL_OFF = RING_BYTES, MISC_OFF = LDSCTL_OFF + 320;
constexpr int LDS_BYTES = 147456;
constexpr int NWAVES = 8, NTHREADS = 512;

#define GAS __attribute__((address_space(1)))
#define LAS __attribute__((address_space(3)))
typedef unsigned short bf16;
typedef unsigned v4u __attribute__((ext_vector_type(4)));
typedef unsigned v2u __attribute__((ext_vector_type(2)));
typedef float f32x4 __attribute__((ext_vector_type(4)));
typedef float f32x2v __attribute__((ext_vector_type(2)));
typedef float f32x16 __attribute__((ext_vector_type(16)));
typedef short bf16x8 __attribute__((ext_vector_type(8)));
typedef short s16x4 __attribute__((ext_vector_type(4)));
typedef __bf16 bf16x2_t __attribute__((ext_vector_type(2)));
typedef GAS unsigned gu32;
#define RLX_AGENT __ATOMIC_RELAXED, __HIP_MEMORY_SCOPE_AGENT
#define LDS_WAIT() asm volatile("s_waitcnt lgkmcnt(0)" ::: "memory")

__device__ __forceinline__ unsigned pk2(float lo, float hi) { f32x2v v = {lo, hi}; bf16x2_t b = __builtin_convertvector(v, bf16x2_t); return __builtin_bit_cast(unsigned, b); }
__device__ __forceinline__ float bflo(unsigned u) { return __uint_as_float(u << 16); }
__device__ __forceinline__ float bfhi(unsigned u) { return __uint_as_float(u & 0xffff0000u); }
__device__ __forceinline__ float sigm(float x) { return __builtin_amdgcn_rcpf(1.f + __expf(-x)); }
__device__ __forceinline__ int row_seq(int row) { return row < MP ? (row >> 12) : NBP + ((row - MP) >> 5); }

namespace pg8 {
#define PG8_LAS __attribute__((address_space(3)))
typedef unsigned short bf16_t;
typedef short bf16x8 __attribute__((ext_vector_type(8)));
typedef float f32x4 __attribute__((ext_vector_type(4)));
typedef unsigned u32x4 __attribute__((ext_vector_type(4)));
constexpr int BM = 256, BK = 64, HALF = 128, HTB = HALF * BK * 2  , STAGE_BYTES = 8 * HTB, NXCD = 8, WGM = 8;

__host__ __device__ __forceinline__ int lds_byte(int r, int c) { const int st = (r >> 4) * 2 + (c >> 5), rr = r & 15, cc = c & 31, ob = rr * 64 + cc * 2; return st * 1024 + (ob ^ (((ob >> 9) & 1) << 5)); }
__host__ __device__ __forceinline__ void stage_rc(int b, int& R, int& C) { const int st = b / 1024, sb = b % 1024, swz = sb ^ (((sb >> 9) & 1) << 5); R = (st >> 1) * 16 + swz / 64; C = (st & 1) * 32 + (swz % 64) / 2; }
__host__ __device__ __forceinline__ int perm32(int rho) { const int n = rho >> 4, i = rho & 15; return 8 * (i >> 2) + 4 * n + (i & 3); }

struct Unit { int pm, pn, kt0, nkt, part; };
struct Gemm { const bf16_t* A; const bf16_t* Bt; int M, N, K; };

struct StaticOrder {
    int nM, nN, nwg, G, c;
    int nkt_all;
    __host__ __device__ void init(int M, int N, int G_, int c_, int K = 0) { nM = M / BM; nN = N / BM; nwg = nM * nN; G = G_; c = c_; nkt_all = K / BK; }
    __host__ __device__ bool next(int i, Unit& u) const {
        const long L = (long)i * G + c; if (L >= nwg) return false;
        int wgid = (int)L; { const int q = nwg / NXCD, r = nwg % NXCD, xcd = wgid % NXCD, off = wgid / NXCD; wgid = (xcd < r ? xcd * (q + 1) : r * (q + 1) + (xcd - r) * q) + off; }
        const int nig = WGM * nN, gid = wgid / nig, fm = gid * WGM, gsz = (nM - fm) < WGM ? (nM - fm) : WGM;
        u.pm = fm + ((wgid % nig) % gsz); u.pn = (wgid % nig) / gsz; u.kt0 = 0; u.nkt = nkt_all; u.part = 0;
        u.pn = (u.pn + gid * (nN / NXCD)) % nN;
        return true;
    }
    __host__ __device__ int count() const { return c < nwg ? (nwg - 1 - c) / G + 1 : 0; }
    __host__ __device__ int count0() const { return (nwg - 1) / G + 1; }
    __device__ __forceinline__ void a_ready(const Unit&) const {}
    __device__ __forceinline__ void done(const Unit&) const {}
};
struct ShiftedTailOrder {
    StaticOrder base; int c, whole, T; unsigned* flags;
    __device__ void init(int M, int N, int G_, int c_, int K, unsigned* fl) { base.init(M, N, G_, c_, K); c = c_; whole = base.nwg / G_; T = base.nwg - whole * G_; flags = fl; if (2 * T > G_ || T == 0) T = -1; }
    __device__ bool next(int i, Unit& u) const {
        if (T < 0 || i < whole) return base.next(i, u);
        if (i == whole && c >= T && c < 2 * T) { StaticOrder b2 = base; b2.c = c - T; const bool ok = b2.next(whole, u); u.part = 9; return ok; }
        return false;
    }
    __device__ int count() const { return T < 0 ? base.count() : whole + ((c >= T && c < 2 * T) ? 1 : 0); }
    __device__ int count0() const { return base.count0(); }
    __device__ __forceinline__ void a_ready(const Unit& u) const {
        if (u.part != 9) return;
        const gu32* fw = (const gu32*)flags + (c - T);
        for (int spin = 0; spin < (1 << 22); ++spin) { if (__hip_atomic_load(fw, RLX_AGENT) != 0u) break; __builtin_amdgcn_s_sleep(2); }
        __builtin_amdgcn_fence(__ATOMIC_ACQUIRE, "agent");
    }
    __device__ __forceinline__ void done(const Unit&) const {}
};
struct TailOrder {
    StaticOrder base; int S, c, G; bool rev;
    __host__ __device__ void init(int N, int G_, int c_, int K, int S_, bool rev_ = false) { base.init(MP, N, G_, c_, K); S = S_; c = c_; G = G_; rev = rev_; }
    __host__ __device__ bool next(int i, Unit& u) const {
        const int nb = base.count();
        if (i < nb) { const bool ok = base.next(i, u); if (rev) u.pm = MP / BM - 1 - u.pm; return ok; }
        if (i > nb || c >= 32 * S) return false;
        const int tile = c / S, p = c % S, nt = base.nkt_all;
        u.pm = MP / BM + tile / base.nN; u.pn = tile % base.nN;
        u.kt0 = (p * nt / S) & ~1; u.nkt = (((p + 1) * nt / S) & ~1) - u.kt0; if (p == S - 1) u.nkt = nt - u.kt0; u.part = p + 1;
        return true;
    }
    __host__ __device__ int count() const { return base.count() + (c < 32 * S ? 1 : 0); }
    __host__ __device__ int count0() const { return base.count0() + 1; }
    __device__ __forceinline__ void a_ready(const Unit&) const {}
    __device__ __forceinline__ void done(const Unit&) const {}
};

#define EPI_FENCE() do {} while (0)
#ifndef PG8_EREP_IN
#define PG8_EREP_IN 1
#endif
#ifndef PG8_EREP_RES
#define PG8_EREP_RES 1
#endif
#ifndef PG8_EREP_SW
#define PG8_EREP_SW 1
#endif
#ifndef PG8_KREP_IN
#define PG8_KREP_IN 1
#endif
#ifndef PG8_KREP_RES
#define PG8_KREP_RES 1
#endif
#define EPI_STEP(off, pitch_bytes, m) do { off += (unsigned)(((m) == 3 ? HALF - 48 : 16) * (pitch_bytes)); asm volatile("" : "+v"(off)); } while (0)
#ifndef EPI_NT
#define EPI_NT 0
#endif
#if EPI_NT
#define EPI_ST(ptr, w) __builtin_nontemporal_store((w), (GAS u32x4*)(ptr))
#else
#define EPI_ST(ptr, w) (*(GAS u32x4*)(ptr) = (w))
#endif
template <class T> __device__ __forceinline__ GAS T* at(T* base, unsigned byte_off) { return (GAS T*)((GAS char*)base + byte_off); }
template <class T> __device__ __forceinline__ const GAS T* at(const T* base, unsigned byte_off) { return (const GAS T*)((const GAS char*)base + byte_off); }

struct EpiIn {
    static constexpr bool PERM = true, AFTER_DRAIN = false; static constexpr int KREP = PG8_KREP_IN, EREP = PG8_EREP_IN;
    bf16_t* QKVG; float* out; int layer;
    __device__ __forceinline__ void operator()(const f32x4 (&acc)[2][2][4][2], const Unit& u, int wr, int wc, int fr, int fq) const {
        const int reg = u.pn >> 2;
        const int rl0 = wr * 64 + fr, cl0 = wc * 32 + 8 * fq;
        bf16_t* tb = QKVG + (size_t)u.pm * BM * INW + (size_t)u.pn * BM;
        unsigned lo = (unsigned)(rl0 * INW + cl0) * 2u; asm volatile("" : "+v"(lo));
        if (reg >= 6) {
#pragma unroll
            for (int ai = 0; ai < 2; ++ai)
#pragma unroll
                for (int m = 0; m < 4; ++m) {
#pragma unroll
                    for (int bj = 0; bj < 2; ++bj) {
                        const f32x4 v0 = acc[ai][bj][m][0] * (1.f / KREP), v1 = acc[ai][bj][m][1] * (1.f / KREP);
                        u32x4 w; w.x = pk2(sigm(v0[0]), sigm(v0[1])); w.y = pk2(sigm(v0[2]), sigm(v0[3])); w.z = pk2(sigm(v1[0]), sigm(v1[1])); w.w = pk2(sigm(v1[2]), sigm(v1[3]));
                        EPI_ST(at(tb, lo + (unsigned)(bj * HALF) * 2u), w);
                    }
                    EPI_STEP(lo, INW * 2, m);
                }
            return;
        }
        const float sc = (reg == 0) ? SCALE_A : (reg == 3 ? SCALE_B : 1.f);
#pragma unroll
        for (int ai = 0; ai < 2; ++ai)
#pragma unroll
            for (int m = 0; m < 4; ++m) {
#pragma unroll
                for (int bj = 0; bj < 2; ++bj) {
                    const f32x4 v0 = acc[ai][bj][m][0] * (sc * (1.f / KREP)), v1 = acc[ai][bj][m][1] * (sc * (1.f / KREP));
                    u32x4 w; w.x = pk2(v0[0], v0[1]); w.y = pk2(v0[2], v0[3]); w.z = pk2(v1[0], v1[1]); w.w = pk2(v1[2], v1[3]);
                    EPI_ST(at(tb, lo + (unsigned)(bj * HALF) * 2u), w);
                }
                EPI_STEP(lo, INW * 2, m);
            }
    }
};

template <bool ADD> struct EpiGate {
    static constexpr bool PERM = true, AFTER_DRAIN = false; static constexpr int KREP = 1, EREP = 1;
    bf16_t* MG; const bf16_t* G; int gcol;
    __device__ __forceinline__ void operator()(const f32x4 (&acc)[2][2][4][2], const Unit& u, int wr, int wc, int fr, int fq) const {
        const int rl0 = wr * 64 + fr, cl0 = wc * 32 + 8 * fq;
        bf16_t* mb = MG + (size_t)u.pm * BM * D + (size_t)u.pn * BM;
        const bf16_t* gb = G + (size_t)u.pm * BM * INW + gcol + (size_t)u.pn * BM;
        unsigned mo = (unsigned)(rl0 * D + cl0) * 2u, go = (unsigned)(rl0 * INW + cl0) * 2u; asm volatile("" : "+v"(mo), "+v"(go));
#pragma unroll
        for (int ai = 0; ai < 2; ++ai)
#pragma unroll
            for (int mh = 0; mh < 2; ++mh) {
                u32x4 g[2][2], o[2][2];
#pragma unroll
                for (int m = 0; m < 2; ++m)
#pragma unroll
                    for (int bj = 0; bj < 2; ++bj) { g[m][bj] = *(const GAS u32x4*)at(gb, go + (unsigned)(m * 16 * INW + bj * HALF) * 2u);
                        if (ADD) o[m][bj] = *(const GAS u32x4*)at(mb, mo + (unsigned)(m * 16 * D + bj * HALF) * 2u); }
#pragma unroll
                for (int m = 0; m < 2; ++m)
#pragma unroll
                    for (int bj = 0; bj < 2; ++bj) {
                        const f32x4 a0 = acc[ai][bj][2 * mh + m][0], a1 = acc[ai][bj][2 * mh + m][1]; const u32x4 gg = g[m][bj];
                        float r0 = a0[0] * bflo(gg.x), r1 = a0[1] * bfhi(gg.x), r2 = a0[2] * bflo(gg.y), r3 = a0[3] * bfhi(gg.y);
                        float r4 = a1[0] * bflo(gg.z), r5 = a1[1] * bfhi(gg.z), r6 = a1[2] * bflo(gg.w), r7 = a1[3] * bfhi(gg.w);
                        if (ADD) { const u32x4 oo = o[m][bj];
                            r0 += bflo(oo.x); r1 += bfhi(oo.x); r2 += bflo(oo.y); r3 += bfhi(oo.y); r4 += bflo(oo.z); r5 += bfhi(oo.z); r6 += bflo(oo.w); r7 += bfhi(oo.w); }
                        u32x4 w; w.x = pk2(r0, r1); w.y = pk2(r2, r3); w.z = pk2(r4, r5); w.w = pk2(r6, r7);
                        *(GAS u32x4*)at(mb, mo + (unsigned)(m * 16 * D + bj * HALF) * 2u) = w;
                    }
                asm volatile("" ::: "memory");
                go += (unsigned)((mh == 1 ? HALF - 32 : 32) * INW * 2); mo += (unsigned)((mh == 1 ? HALF - 32 : 32) * D * 2); asm volatile("" : "+v"(go), "+v"(mo));
            }
    }
};

struct EpiRes {
    static constexpr bool PERM = true, AFTER_DRAIN = false; static constexpr int KREP = PG8_KREP_RES, EREP = PG8_EREP_RES;
    const float* xp; const float* xs; const float* gate; bf16_t* pre; float* slab;
    const float* xstat; const float* xg; const float* xbias;
    __device__ __forceinline__ void operator()(const f32x4 (&acc)[2][2][4][2], const Unit& u, int wr, int wc, int fr, int fq) const {
        const int rl0 = wr * 64 + fr, cl0 = wc * 32 + 8 * fq;
        const bool samp = u.pm >= MP / BM;
        const float* xb = (samp ? xs + (size_t)(u.pm - MP / BM) * BM * D : xp + (size_t)u.pm * BM * D) + (size_t)u.pn * BM;
        const float* gbase = gate + (size_t)(samp ? NBP + 8 * (u.pm - MP / BM) : (u.pm >> 4)) * MODW + (size_t)u.pn * BM;
        unsigned xo = (unsigned)(rl0 * D + cl0) * 4u, gl = (unsigned)cl0 * 4u; asm volatile("" : "+v"(xo), "+v"(gl));
        if (!samp) {
            bf16_t* pb = pre + (size_t)u.pm * BM * D + (size_t)u.pn * BM;
            f32x4 g[2][2];
#pragma unroll
            for (int bj = 0; bj < 2; ++bj)
#pragma unroll
                for (int n = 0; n < 2; ++n) g[bj][n] = *(const GAS f32x4*)at(gbase, gl + (unsigned)(bj * HALF + n * 4) * 4u);
            if (xstat) {
                const float* st = xstat + (size_t)u.pm * BM * 2;
#pragma unroll
                for (int bj = 0; bj < 2; ++bj) {
                    f32x4 ga[2], ba[2];
#pragma unroll
                    for (int n = 0; n < 2; ++n) { ga[n] = *(const GAS f32x4*)at(xg + (size_t)u.pn * BM, gl + (unsigned)(bj * HALF + n * 4) * 4u) * ALPHA; ba[n] = *(const GAS f32x4*)at(xbias + (size_t)u.pn * BM, gl + (unsigned)(bj * HALF + n * 4) * 4u) * ALPHA; }
                    unsigned so = (unsigned)rl0 * 8u, po = (xo >> 1) + (unsigned)(bj * HALF) * 2u; asm volatile("" : "+v"(so), "+v"(po));
#pragma unroll
                    for (int ai = 0; ai < 2; ++ai) {
                        u32x4 pr[4]; f32x2v ms[4];
#pragma unroll
                        for (int m = 0; m < 4; ++m) { ms[m] = *(const GAS f32x2v*)at(st, so + (unsigned)(m * 16) * 8u); pr[m] = *(const GAS u32x4*)at(pb, po + (unsigned)(m * 16 * D) * 2u); }
#pragma unroll
                        for (int m = 0; m < 4; ++m) {
                            const f32x4 p0 = {bflo(pr[m].x), bfhi(pr[m].x), bflo(pr[m].y), bfhi(pr[m].y)}, p1 = {bflo(pr[m].z), bfhi(pr[m].z), bflo(pr[m].w), bfhi(pr[m].w)};
                            const f32x4 v0 = (p0 - ms[m][0]) * ms[m][1] * ga[0] + ba[0] + g[bj][0] * (acc[ai][bj][m][0] * (1.f / KREP));
                            const f32x4 v1 = (p1 - ms[m][0]) * ms[m][1] * ga[1] + ba[1] + g[bj][1] * (acc[ai][bj][m][1] * (1.f / KREP));
                            u32x4 w; w.x = pk2(v0[0], v0[1]); w.y = pk2(v0[2], v0[3]); w.z = pk2(v1[0], v1[1]); w.w = pk2(v1[2], v1[3]);
                            *(GAS u32x4*)at(pb, po + (unsigned)(m * 16 * D) * 2u) = w;
                        }
                        asm volatile("" ::: "memory");
                        po += (unsigned)(HALF * D * 2); so += (unsigned)(HALF * 8); asm volatile("" : "+v"(po), "+v"(so));
                    }
                }
                return;
            }
#pragma unroll
            for (int bj = 0; bj < 2; ++bj) {
                unsigned xq = xo + (unsigned)(bj * HALF) * 4u; asm volatile("" : "+v"(xq));
#pragma unroll
                for (int ai = 0; ai < 2; ++ai) {
                    f32x4 x[4][2];
#pragma unroll
                    for (int m = 0; m < 4; ++m)
#pragma unroll
                        for (int n = 0; n < 2; ++n) x[m][n] = *(const GAS f32x4*)at(xb, xq + (unsigned)(m * 16 * D + n * 4) * 4u);
#pragma unroll
                    for (int m = 0; m < 4; ++m) {
                        const f32x4 v0 = x[m][0] * ALPHA + g[bj][0] * (acc[ai][bj][m][0] * (1.f / KREP)), v1 = x[m][1] * ALPHA + g[bj][1] * (acc[ai][bj][m][1] * (1.f / KREP));
                        u32x4 w; w.x = pk2(v0[0], v0[1]); w.y = pk2(v0[2], v0[3]); w.z = pk2(v1[0], v1[1]); w.w = pk2(v1[2], v1[3]);
                        *(GAS u32x4*)at(pb, (xq >> 1) + (unsigned)(m * 16 * D) * 2u) = w;
                    }
                    asm volatile("" ::: "memory");
                    xq += (unsigned)(HALF * D * 4); asm volatile("" : "+v"(xq));
                }
            }
            return;
        }
        float* sb = slab + ((size_t)(u.part > 0 ? u.part - 1 : 0) * MS + (size_t)(u.pm - MP / BM) * BM) * D + (size_t)u.pn * BM;
#pragma unroll
        for (int ai = 0; ai < 2; ++ai)
#pragma unroll
            for (int m = 0; m < 4; ++m) {
                const unsigned go = gl + (unsigned)((rl0 + ai * HALF + m * 16) >> 5) * (unsigned)(MODW * 4);
#pragma unroll
                for (int bj = 0; bj < 2; ++bj)
#pragma unroll
                    for (int n = 0; n < 2; ++n) {
                        const unsigned co = (unsigned)(bj * HALF + n * 4) * 4u, ro = (unsigned)((ai * HALF + m * 16) * D) * 4u;
                        const f32x4 g = *(const GAS f32x4*)at(gbase, go + co);
                        f32x4 v = g * (acc[ai][bj][m][n] * (1.f / KREP));
                        if (u.part <= 1) v = v + *(const GAS f32x4*)at(xb, xo + ro + co) * ALPHA;
                        *(GAS f32x4*)at(sb, xo + ro + co) = v;
                    }
            }
    }
};

struct EpiSwiGLU {
    static constexpr bool PERM = true, AFTER_DRAIN = false; static constexpr int KREP = 1, EREP = PG8_EREP_SW;
    bf16_t* HID;
    __device__ __forceinline__ void operator()(const f32x4 (&acc)[2][2][4][2], const Unit& u, int wr, int wc, int fr, int fq) const {
        const int rl0 = wr * 64 + fr, cl0 = wc * 32 + 8 * fq;
        bf16_t* hb = HID + (size_t)u.pm * BM * FF + (size_t)u.pn * HALF;
        unsigned ho = (unsigned)(rl0 * FF + cl0) * 2u; asm volatile("" : "+v"(ho));
#pragma unroll
        for (int ai = 0; ai < 2; ++ai)
#pragma unroll
            for (int m = 0; m < 4; ++m) {
                float r[8];
#pragma unroll
                for (int n = 0; n < 2; ++n)
#pragma unroll
                    for (int e = 0; e < 4; ++e) { const float a = acc[ai][0][m][n][e], b = acc[ai][1][m][n][e]; r[4 * n + e] = a * sigm(a) * b; }
                u32x4 w; w.x = pk2(r[0], r[1]); w.y = pk2(r[2], r[3]); w.z = pk2(r[4], r[5]); w.w = pk2(r[6], r[7]);
                EPI_ST(at(hb, ho), w);
                EPI_STEP(ho, FF * 2, m);
            }
    }
};

template <class Epi, class Sched, bool ALIGN_EPI = false, bool SP2 = false>
__device__ __forceinline__ void gemm_phase(PG8_LAS unsigned char* lds, const Gemm g, const Sched& S, const Epi& E, const unsigned unit_ticks = 0u  ) {
    int tid_ = threadIdx.x; asm volatile("" : "+v"(tid_));
    const int tid = tid_, wid = __builtin_amdgcn_readfirstlane(tid >> 6), lane = tid & 63, wr = wid >> 2, wc = wid & 3, fr = lane & 15, fq = lane >> 4;
    const int K = g.K;
    unsigned voffA[2], voffB[2];
#pragma unroll
    for (int i = 0; i < 2; ++i) { int R, C; stage_rc(tid * 16 + i * 8192, R, C); const int Rb = Epi::PERM ? ((R & ~31) + perm32(R & 31)) : R;
        voffA[i] = (unsigned)(R * K + C) * 2u; voffB[i] = (unsigned)(Rb * K + C) * 2u; }
    const size_t kstep = (size_t)(BK * 2);
    const size_t hstep = (size_t)HALF * K * 2;
    const size_t tstep = 2 * hstep;
    const unsigned ldsw = (unsigned)wid * 1024u;
    const int aoff = lds_byte(wr * 64 + fr, fq * 8), boff = lds_byte(wc * 32 + fr, fq * 8);
#define PG8_SA(b, h) (((b) * 2 + (h)) * HTB)
#define PG8_SB(b, h) ((4 + (b) * 2 + (h)) * HTB)
#define PG8_STAGE(bufoff, gbase, voff) do { _Pragma("unroll") for (int _i = 0; _i < 2; ++_i) \
        __builtin_amdgcn_global_load_lds((const unsigned*)((const char*)(gbase) + (voff)[_i]), (PG8_LAS unsigned*)(lds + (bufoff) + ldsw + _i * 8192), 16, 0, 0); } while (0)
#define PG8_LDA(dst, b, h) do { _Pragma("unroll") for (int m = 0; m < 4; ++m) _Pragma("unroll") for (int k = 0; k < 2; ++k) dst[m][k] = *(const PG8_LAS bf16x8*)(lds + PG8_SA(b, h) + aoff + m * 2048 + k * 1024); } while (0)
#define PG8_LDB(dst, b, h) do { _Pragma("unroll") for (int n = 0; n < 2; ++n) _Pragma("unroll") for (int k = 0; k < 2; ++k) dst[n][k] = *(const PG8_LAS bf16x8*)(lds + PG8_SB(b, h) + boff + n * 2048 + k * 1024); } while (0)
#define PG8_MMA(ai, bj, At, Bt) do { __builtin_amdgcn_s_setprio(1); _Pragma("unroll") for (int m = 0; m < 4; ++m) _Pragma("unroll") for (int n = 0; n < 2; ++n) _Pragma("unroll") for (int k = 0; k < 2; ++k) \
        acc[ai][bj][m][n] = __builtin_amdgcn_mfma_f32_16x16x32_bf16(Bt[n][k], At[m][k], acc[ai][bj][m][n], 0, 0, 0); __builtin_amdgcn_s_setprio(0); } while (0)
#define PG8_WAIT_V(n) asm volatile("s_waitcnt vmcnt(" #n ")" ::: "memory")
#define PG8_WAIT_L(n) asm volatile("s_waitcnt lgkmcnt(" #n ")" ::: "memory")
#define PG8_BAR __builtin_amdgcn_s_barrier()
#define PG8_SCHED __builtin_amdgcn_sched_barrier(0)
    Unit cur, nxt; int ui = 0;
    if (!S.next(0, cur)) return;
    if (unit_ticks) {
        const int gq = (S.c >> 3) & 7; const bool shortwg = S.count() < S.count0();
        const unsigned long long dly = shortwg ? (unsigned long long)(unit_ticks / 8u) * (unsigned)gq : (unsigned long long)(unit_ticks / 16u) * (unsigned)(gq & 3);
        const unsigned long long t0 = __builtin_amdgcn_s_memrealtime();
        while (__builtin_amdgcn_s_memrealtime() - t0 < dly) __builtin_amdgcn_s_sleep(16);
    }
    f32x4 acc[2][2][4][2];
#pragma unroll
    for (int a = 0; a < 2; ++a)
#pragma unroll
        for (int b = 0; b < 2; ++b)
#pragma unroll
            for (int m = 0; m < 4; ++m)
#pragma unroll
                for (int n = 0; n < 2; ++n) acc[a][b][m][n] = (f32x4){0.f, 0.f, 0.f, 0.f};
    bf16x8 At[4][2], B0[2][2], B1[2][2];
    const char* cA = (const char*)g.A + (size_t)cur.pm * tstep + (size_t)cur.kt0 * kstep; const char* cB = (const char*)g.Bt + (size_t)cur.pn * tstep + (size_t)cur.kt0 * kstep;
    int nt = cur.nkt;
    S.a_ready(cur);
    if constexpr (SP2) {
        PG8_STAGE(PG8_SB(0, 0), cB, voffB); PG8_STAGE(PG8_SB(0, 1), cB + hstep, voffB); PG8_STAGE(PG8_SA(0, 0), cA, voffA); PG8_STAGE(PG8_SA(0, 1), cA + hstep, voffA);
        if (wr == 1) PG8_BAR;
        PG8_WAIT_V(2); PG8_BAR;
        PG8_STAGE(PG8_SB(1, 0), cB + kstep, voffB); PG8_STAGE(PG8_SA(1, 0), cA + kstep, voffA); PG8_STAGE(PG8_SB(1, 1), cB + hstep + kstep, voffB);
        PG8_WAIT_V(6); PG8_BAR;
    } else {
        PG8_STAGE(PG8_SB(0, 0), cB, voffB); PG8_STAGE(PG8_SA(0, 0), cA, voffA); PG8_STAGE(PG8_SB(0, 1), cB + hstep, voffB); PG8_STAGE(PG8_SA(0, 1), cA + hstep, voffA);
        if (wr == 1) PG8_BAR;
        PG8_WAIT_V(4); PG8_BAR;
        PG8_STAGE(PG8_SB(1, 0), cB + kstep, voffB); PG8_STAGE(PG8_SA(1, 0), cA + kstep, voffA); PG8_STAGE(PG8_SB(1, 1), cB + hstep + kstep, voffB);
        PG8_WAIT_V(6); PG8_BAR;
    }
    for (;;) {
        const bool has_next = S.next(ui + 1, nxt);
        const char* nA = has_next ? (const char*)g.A + (size_t)nxt.pm * tstep + (size_t)nxt.kt0 * kstep : cA; const char* nB = has_next ? (const char*)g.Bt + (size_t)nxt.pn * tstep + (size_t)nxt.kt0 * kstep : cB;
#ifndef PG8_KREP
#define PG8_KREP 1
#endif
        for (int t2 = 0; t2 < Epi::KREP * nt; t2 += 2) {
            const int t = Epi::KREP == 1 ? t2 : t2 % nt;
            const bool last = (t2 == Epi::KREP * nt - 2);
            const char* a1 = cA + (size_t)(t + 1) * kstep;
            const int t2n = Epi::KREP == 1 ? t + 2 : (t + 2) % nt;
            const char* a2 = last ? nA : cA + (size_t)t2n * kstep; const char* b2 = last ? nB : cB + (size_t)t2n * kstep;
            const char* a3 = a2 + kstep; const char* b3 = b2 + kstep;
            if (last && has_next) S.a_ready(nxt);
            if constexpr (SP2) {
            PG8_LDB(B0, 0, 0); PG8_LDB(B1, 0, 1); PG8_SCHED; PG8_LDA(At, 0, 0); PG8_STAGE(PG8_SA(1, 1), a1 + hstep, voffA);
            PG8_WAIT_V(8); PG8_WAIT_L(0); PG8_BAR; PG8_MMA(0, 0, At, B0); PG8_MMA(0, 1, At, B1); PG8_BAR; PG8_SCHED;
            PG8_LDA(At, 0, 1); PG8_STAGE(PG8_SB(0, 0), b2, voffB); PG8_STAGE(PG8_SB(0, 1), b2 + hstep, voffB); PG8_STAGE(PG8_SA(0, 0), a2, voffA);
            PG8_WAIT_V(8); PG8_WAIT_L(0); PG8_BAR; PG8_MMA(1, 0, At, B0); PG8_MMA(1, 1, At, B1); PG8_BAR; PG8_SCHED;
            PG8_LDB(B0, 1, 0); PG8_LDB(B1, 1, 1); PG8_SCHED; PG8_LDA(At, 1, 0); PG8_STAGE(PG8_SA(0, 1), a2 + hstep, voffA);
            PG8_WAIT_V(8); PG8_WAIT_L(0); PG8_BAR; PG8_MMA(0, 0, At, B0); PG8_MMA(0, 1, At, B1); PG8_BAR; PG8_SCHED;
            PG8_LDA(At, 1, 1); PG8_STAGE(PG8_SB(1, 0), b3, voffB); PG8_STAGE(PG8_SB(1, 1), b3 + hstep, voffB); PG8_STAGE(PG8_SA(1, 0), a3, voffA);
            PG8_WAIT_V(8); PG8_WAIT_L(0); PG8_BAR; PG8_MMA(1, 0, At, B0); PG8_MMA(1, 1, At, B1); PG8_BAR; PG8_SCHED;
            } else {
            PG8_LDB(B0, 0, 0); PG8_SCHED; PG8_LDA(At, 0, 0); PG8_STAGE(PG8_SA(1, 1), a1 + hstep, voffA);
            PG8_WAIT_L(8); PG8_BAR; PG8_WAIT_L(0); PG8_MMA(0, 0, At, B0); PG8_BAR; PG8_SCHED;
            PG8_LDB(B1, 0, 1); PG8_STAGE(PG8_SB(0, 0), b2, voffB);
            PG8_BAR; PG8_WAIT_L(0); PG8_MMA(0, 1, At, B1); PG8_BAR;
            PG8_LDA(At, 0, 1); PG8_STAGE(PG8_SA(0, 0), a2, voffA);
            PG8_BAR; PG8_WAIT_L(0); PG8_MMA(1, 0, At, B0); PG8_BAR; PG8_SCHED;
            PG8_STAGE(PG8_SB(0, 1), b2 + hstep, voffB);
            PG8_WAIT_V(6); PG8_BAR; PG8_MMA(1, 1, At, B1); PG8_BAR;
            PG8_LDB(B0, 1, 0); PG8_SCHED; PG8_LDA(At, 1, 0); PG8_STAGE(PG8_SA(0, 1), a2 + hstep, voffA);
            PG8_WAIT_L(8); PG8_BAR; PG8_WAIT_L(0); PG8_MMA(0, 0, At, B0); PG8_BAR; PG8_SCHED;
            PG8_LDB(B1, 1, 1); PG8_STAGE(PG8_SB(1, 0), b3, voffB);
            PG8_BAR; PG8_WAIT_L(0); PG8_MMA(0, 1, At, B1); PG8_BAR;
            PG8_LDA(At, 1, 1); PG8_STAGE(PG8_SA(1, 0), a3, voffA);
            PG8_BAR; PG8_WAIT_L(0); PG8_MMA(1, 0, At, B0); PG8_BAR; PG8_SCHED;
            PG8_STAGE(PG8_SB(1, 1), b3 + hstep, voffB);
            PG8_WAIT_V(6); PG8_BAR; PG8_MMA(1, 1, At, B1); PG8_BAR;
            }
        }
        if constexpr (ALIGN_EPI) { if (wr == 0) PG8_BAR; }
        if constexpr (!Epi::AFTER_DRAIN) { E(acc, cur, wr, wc, fr, fq); if constexpr (Epi::EREP > 1) { asm volatile("" ::: "memory"); E(acc, cur, wr, wc, fr, fq); } S.done(cur); }
        if (!has_next) break;
#pragma unroll
        for (int a = 0; a < 2; ++a)
#pragma unroll
            for (int b = 0; b < 2; ++b)
#pragma unroll
                for (int m = 0; m < 4; ++m)
#pragma unroll
                    for (int n = 0; n < 2; ++n) acc[a][b][m][n] = (f32x4){0.f, 0.f, 0.f, 0.f};
        cur = nxt; cA = nA; cB = nB; nt = cur.nkt; ++ui;
        if constexpr (ALIGN_EPI) { if (wr == 1) PG8_BAR; }
    }
    PG8_WAIT_V(0);
    if constexpr (!ALIGN_EPI) { if (wr == 0) PG8_BAR; }
    PG8_BAR;
    if constexpr (Epi::AFTER_DRAIN) { E.fused(acc, cur, wr, wc, fr, fq, lds, wid, lane); S.done(cur); }
#undef PG8_SA
#undef PG8_SB
#undef PG8_STAGE
#undef PG8_LDA
#undef PG8_LDB
#undef PG8_MMA
#undef PG8_WAIT_V
#undef PG8_WAIT_L
#undef PG8_BAR
#undef PG8_SCHED
}
}

namespace att {
constexpr int NSLOT = 3, L_K = 0, L_V = 49152, L_TAB = 98304, L_XCH = 0;
__device__ __forceinline__ unsigned off_b(unsigned row, unsigned ch) { return 256u * row + 16u * (ch ^ (((row & 3u) << 2) | ((row >> 2) & 3u))); }
#define MFMA32(a, b, c) __builtin_amdgcn_mfma_f32_32x32x16_bf16((a), (b), (c), 0, 0, 0)
__device__ __forceinline__ void glds16(const void* gsrc, unsigned lds_dst) { unsigned keep;
    asm volatile("s_mov_b32 %0, m0\n\ts_mov_b32 m0, %2\n\ts_nop 0\n\tglobal_load_lds_dwordx4 %1, off\n\ts_mov_b32 m0, %0" : "=&s"(keep) : "v"(gsrc), "s"(lds_dst) : "memory"); }
__device__ __forceinline__ s16x4 vtr(const LAS unsigned char* p) { return __builtin_bit_cast(s16x4, __builtin_amdgcn_ds_read_tr16_b64_v4i16((LAS s16x4*)p)); }

struct Ctx {
    const bf16* QKVG;
    const float *cak, *cav, *cbk, *cbv;
    bf16 *OA, *OB;
    const float* subln;
    float lam, osc;
};

__device__ __forceinline__ void build_tables(LAS unsigned char* lds, const float* t5, const float* relb  ) {
    LAS float* tab = (LAS float*)(lds + L_TAB);
    int tid_ = threadIdx.x; asm volatile("" : "+v"(tid_));
#pragma unroll 1
    for (int e = tid_; e < 2 * 8 * 256; e += NTHREADS) {
        const int mode = e >> 11, hh = (e >> 8) & 7, idx = e & 255, rel = idx - 191;
        float v;
        if (mode == 0) {
            const int n = rel < 0 ? -rel : rel;
            int bk = n < 8 ? n : (n < 12 ? 8 : n < 16 ? 9 : n < 23 ? 10 : n < 32 ? 11 : n < 46 ? 12 : n < 64 ? 13 : n < 91 ? 14 : 15);
            if (rel > 0) bk += 16;
            v = t5[bk * 8 + hh];
        } else {
            int rb = rel < -128 ? -128 : (rel > 128 ? 128 : rel);
            v = relb[(rb + 128) * 8 + hh];
        }
        tab[e] = v * LOG2E;
    }
    __syncthreads();
}

template <int MODE, bool SAMPLE>
__device__ __forceinline__ void unit(LAS unsigned char* lds, const Ctx& C, const int b, const int hh, const int u) {
    constexpr int DK = MODE == 0 ? 64 : 128, NS = DK / 16;
    int tid_ = threadIdx.x; asm volatile("" : "+v"(tid_));
    const int tid = tid_, lane = tid & 63, wid = __builtin_amdgcn_readfirstlane(tid >> 6);
    const int r = lane & 31, h = lane >> 5;
    int t = 0, cw, p_lo, p_hi, wp_lo = 0, qrow0, qpos0; bool has = true;
    if (MODE == 0 && !SAMPLE) { t = wid & 1; const int sub = wid >> 1; qpos0 = 128 * u + 32 * sub; qrow0 = b * SEQ + qpos0; cw = 2 * u + (sub >> 1); p_lo = 0; p_hi = 2 * u + 1; }
    if (MODE == 1 && !SAMPLE) { qpos0 = 256 * u + 32 * wid; qrow0 = b * SEQ + qpos0; cw = 4 * u + (wid >> 1); p_lo = 4 * u - 8 < 0 ? 0 : 4 * u - 8; p_hi = 4 * u + 3; wp_lo = cw - 8; }
    if (MODE == 0 && SAMPLE) { t = wid & 1; has = (wid >> 1) == 0; qpos0 = PAST; qrow0 = MP + b * TS; cw = 16; p_lo = 0; p_hi = 16; }
    if (MODE == 1 && SAMPLE) { has = wid == 0; qpos0 = PAST; qrow0 = MP + b * TS; cw = 16; p_lo = 8; p_hi = 16; wp_lo = 8; }
    const LAS float* tab = (const LAS float*)(lds + L_TAB) + (MODE * 8 + hh) * 256;
    const float cfar = tab[0];
    bf16x8 qf[NS];
    {
        const bf16* qp = C.QKVG + (size_t)(qrow0 + r) * INW + (MODE == 0 ? C_QA + hh * 128 + t * 64 : C_QB + hh * 128) + 8 * h;
#pragma unroll
        for (int s = 0; s < NS; ++s) qf[s] = has ? *(const GAS bf16x8*)(qp + 16 * s) : (bf16x8){0, 0, 0, 0, 0, 0, 0, 0};
    }
    constexpr float THR = 8.f;
    float mref = 0.f, lsum = 0.f;
    f32x16 iniF;
#pragma unroll
    for (int i = 0; i < 16; ++i) iniF[i] = cfar;
    bool first = true;
    f32x16 o[4];
#pragma unroll
    for (int c = 0; c < 4; ++c)
#pragma unroll
        for (int i = 0; i < 16; ++i) o[c][i] = 0.f;
    const unsigned xk = ((unsigned)(r & 3) << 2) | ((unsigned)(r >> 2) & 3u);
    const int q4 = (lane & 15) >> 2, p4 = lane & 3, blk = (lane >> 4) & 1;
    unsigned vbase[2][4];
#pragma unroll
    for (int tt = 0; tt < 2; ++tt)
#pragma unroll
        for (int c = 0; c < 4; ++c) {
            const unsigned ch = (unsigned)(4 * c + 2 * blk + (p4 >> 1)), x = ((unsigned)q4 << 2) | ((unsigned)(2 * tt + h) & 3u);
            vbase[tt][c] = 256u * (unsigned)(8 * tt + 4 * h + q4) + 16u * (ch ^ x) + 8u * (unsigned)(p4 & 1);
        }
    const int kcol = (MODE == 0 ? C_KA : C_KB) + hh * 128, vcol = (MODE == 0 ? C_VA : C_VB) + hh * 128;

    const int drow = 4 * wid + (lane >> 4);
    const unsigned dsrc = (unsigned)(drow * INW + 8 * ((lane & 15) ^ ((((lane >> 4) & 3) << 2) | (wid & 3)))) * 2u;
    f32x4 ck0[2], ck1[2], cv0[2], cv1[2];
#define ATT_ISSUE(pp, bb) do { \
        LAS unsigned char* Kd_ = lds + L_K + (bb) * 16384 + wid * 1024; LAS unsigned char* Vd_ = lds + L_V + (bb) * 16384 + wid * 1024;     \
        if (SAMPLE && (pp) < 16) { \
            const float* ck_ = (MODE == 0 ? C.cak + ((size_t)b * PAST + 64 * (pp)) * 1024 : C.cbk + ((size_t)b * BPAST + 64 * ((pp) - 8)) * 1024) + hh * 128; \
            const float* cv_ = (MODE == 0 ? C.cav + ((size_t)b * PAST + 64 * (pp)) * 1024 : C.cbv + ((size_t)b * BPAST + 64 * ((pp) - 8)) * 1024) + hh * 128; \
            _Pragma("unroll") for (int i_ = 0; i_ < 2; ++i_) { const int id_ = tid + NTHREADS * i_, row_ = id_ >> 4, ch_ = id_ & 15; \
                ck0[i_] = *(const GAS f32x4*)(ck_ + (size_t)row_ * 1024 + ch_ * 8); ck1[i_] = *(const GAS f32x4*)(ck_ + (size_t)row_ * 1024 + ch_ * 8 + 4); \
                cv0[i_] = *(const GAS f32x4*)(cv_ + (size_t)row_ * 1024 + ch_ * 8); cv1[i_] = *(const GAS f32x4*)(cv_ + (size_t)row_ * 1024 + ch_ * 8 + 4); } \
        } else { \
            const bf16* tb_ = C.QKVG + (SAMPLE ? (size_t)(MP + b * TS) : (size_t)b * SEQ + (size_t)64 * (pp)) * INW; \
            const char* ks_ = (const char*)(tb_ + kcol) + dsrc; const char* vs_ = (const char*)(tb_ + vcol) + dsrc; \
            const unsigned kd_ = (unsigned)__builtin_amdgcn_readfirstlane((int)(unsigned)(uintptr_t)Kd_), vd_ = (unsigned)__builtin_amdgcn_readfirstlane((int)(unsigned)(uintptr_t)Vd_); \
            glds16(ks_, kd_); glds16(vs_, vd_); \
            if (!SAMPLE) { glds16(ks_ + (size_t)32 * INW * 2, kd_ + 8192u); glds16(vs_ + (size_t)32 * INW * 2, vd_ + 8192u); } \
        } } while (0)
#define ATT_FINISH(pp, bb) do { if (SAMPLE && (pp) < 16) { \
        LAS unsigned char* Kt_ = lds + L_K + (bb) * 16384; LAS unsigned char* Vt_ = lds + L_V + (bb) * 16384; \
        _Pragma("unroll") for (int i_ = 0; i_ < 2; ++i_) { const int id_ = tid + NTHREADS * i_, row_ = id_ >> 4, ch_ = id_ & 15; \
            v4u kw_, vw_; kw_.x = pk2(ck0[i_][0], ck0[i_][1]); kw_.y = pk2(ck0[i_][2], ck0[i_][3]); kw_.z = pk2(ck1[i_][0], ck1[i_][1]); kw_.w = pk2(ck1[i_][2], ck1[i_][3]); \
            vw_.x = pk2(cv0[i_][0], cv0[i_][1]); vw_.y = pk2(cv0[i_][2], cv0[i_][3]); vw_.z = pk2(cv1[i_][0], cv1[i_][1]); vw_.w = pk2(cv1[i_][2], cv1[i_][3]); \
            const unsigned off_ = off_b((unsigned)row_, (unsigned)ch_); \
            *(LAS v4u*)(Kt_ + off_) = kw_; *(LAS v4u*)(Vt_ + off_) = vw_; } } } while (0)

    ATT_ISSUE(p_lo, 0); ATT_FINISH(p_lo, 0);
    if (!SAMPLE) {
        asm volatile("s_waitcnt vmcnt(0)" ::: "memory");
#pragma unroll
        for (int s = 0; s < NS; ++s) asm volatile("" : "+v"(qf[s]));
        if (p_lo + 1 <= p_hi) ATT_ISSUE(p_lo + 1, 1);
    }
    int slot = 0;
    for (int p = p_lo; p <= p_hi; ++p) {
        const int slot1 = slot == NSLOT - 1 ? 0 : slot + 1, slot2 = slot1 == NSLOT - 1 ? 0 : slot1 + 1;
        LAS unsigned char* Kt = lds + L_K + slot * 16384;
        LAS unsigned char* Vt = lds + L_V + slot * 16384;
        if (!SAMPLE && p + 1 <= p_hi) asm volatile("s_waitcnt vmcnt(4)" ::: "memory");
        else asm volatile("s_waitcnt vmcnt(0)" ::: "memory");
        asm volatile("s_waitcnt lgkmcnt(0)" ::: "memory"); __builtin_amdgcn_s_barrier(); asm volatile("" ::: "memory");
        if (SAMPLE) { if (p < p_hi) ATT_ISSUE(p + 1, slot1); }
        else if (p + 2 <= p_hi) ATT_ISSUE(p + 2, slot2);
        if (has && p >= wp_lo && p <= cw) {
            const int nkb = (SAMPLE && p == 16) ? 1 : 2;
            const bool nearb = p >= cw - 2;
            constexpr int NPRE = 1;
            bf16x8 vpre[NPRE][4];
#pragma unroll
            for (int s2 = 0; s2 < NPRE; ++s2)
#pragma unroll
                for (int c = 0; c < 4; ++c) if (!SAMPLE) { const s16x4 lo = vtr(Vt + 256 * 16 * s2 + vbase[0][c]), hi = vtr(Vt + 256 * 16 * s2 + vbase[1][c]); vpre[s2][c] = __builtin_shufflevector(lo, hi, 0, 1, 2, 3, 4, 5, 6, 7); }
            f32x16 sx[2];
#pragma unroll
            for (int kb = 0; kb < 2; ++kb) {
                if (kb < nkb) {
#pragma unroll
                    for (int s = 0; s < NS; ++s) {
                        const unsigned ch = (unsigned)(2 * ((MODE == 0 ? 4 * t : 0) + s) + h);
                        const bf16x8 kf = *(const LAS bf16x8*)(Kt + 256u * (unsigned)(32 * kb + r) + 16u * (ch ^ xk));
                        sx[kb] = s == 0 ? MFMA32(kf, qf[0], iniF) : MFMA32(kf, qf[s], sx[kb]);
                    }
                    if (nearb) {
                        const LAS float* tp = tab + (64 * p + 32 * kb + 4 * h - (qpos0 + r) + 191);
#pragma unroll
                        for (int i = 0; i < 16; ++i) sx[kb][i] += tp[(i & 3) + 8 * (i >> 2)] - cfar;
                    }
                } else {
#pragma unroll
                    for (int i = 0; i < 16; ++i) sx[kb][i] = -INFINITY;
                }
            }
            float mx = fmaxf(fmaxf(sx[0][0], sx[0][1]), sx[1][0]);
#pragma unroll
            for (int i = 2; i < 16; i += 2) mx = fmaxf(fmaxf(mx, sx[0][i]), sx[0][i + 1]);
#pragma unroll
            for (int i = 1; i < 15; i += 2) mx = fmaxf(fmaxf(mx, sx[1][i]), sx[1][i + 1]);
            mx = fmaxf(mx, sx[1][15]);
            { const auto rr = __builtin_amdgcn_permlane32_swap(__float_as_uint(mx), __float_as_uint(mx), false, false);
              mx = fmaxf(__uint_as_float(rr[0]), __uint_as_float(rr[1])); }
            if (first || __any(mx > THR)) {
                const float d = first ? mx : fmaxf(mx, 0.f), al = __builtin_amdgcn_exp2f(-d);
                mref += d; lsum *= al;
#pragma unroll
                for (int kb = 0; kb < 2; ++kb)
#pragma unroll
                    for (int i = 0; i < 16; ++i) sx[kb][i] -= d;
                if (!first) {
#pragma unroll
                    for (int c = 0; c < 4; ++c)
#pragma unroll
                        for (int i = 0; i < 16; ++i) o[c][i] *= al;
                }
#pragma unroll
                for (int i = 0; i < 16; ++i) iniF[i] = cfar - mref;
                first = false;
            }
            f32x2v ps2 = {0.f, 0.f};
#pragma unroll
            for (int kb = 0; kb < 2; ++kb)
#pragma unroll
                for (int i = 0; i < 16; i += 2) { const float e0 = __builtin_amdgcn_exp2f(sx[kb][i]), e1 = __builtin_amdgcn_exp2f(sx[kb][i + 1]); sx[kb][i] = e0; sx[kb][i + 1] = e1; ps2 += (f32x2v){e0, e1}; }
            lsum += ps2[0] + ps2[1];
#pragma unroll
            for (int kb = 0; kb < 2; ++kb) {
                if (kb < nkb) {
#pragma unroll
                    for (int s2 = 0; s2 < 2; ++s2) {
                        v4u pw; pw.x = pk2(sx[kb][8 * s2 + 0], sx[kb][8 * s2 + 1]); pw.y = pk2(sx[kb][8 * s2 + 2], sx[kb][8 * s2 + 3]);
                        pw.z = pk2(sx[kb][8 * s2 + 4], sx[kb][8 * s2 + 5]); pw.w = pk2(sx[kb][8 * s2 + 6], sx[kb][8 * s2 + 7]);
                        const bf16x8 pf = __builtin_bit_cast(bf16x8, pw);
                        const LAS unsigned char* vb = Vt + 256 * (32 * kb + 16 * s2);
#pragma unroll
                        for (int c = 0; c < 4; ++c) {
                            bf16x8 vf;
                            if (!SAMPLE && kb == 0 && s2 < NPRE) vf = vpre[s2 < NPRE ? s2 : 0][c];
                            else { const s16x4 lo = vtr(vb + vbase[0][c]), hi = vtr(vb + vbase[1][c]); vf = __builtin_shufflevector(lo, hi, 0, 1, 2, 3, 4, 5, 6, 7); }
#if defined(PROBE_VRD2)
                            if (!SAMPLE && MODE == 0) { const s16x4 lo2 = vtr(vb + vbase[0][c] + 16384), hi2 = vtr(vb + vbase[1][c] + 16384); asm volatile("" :: "v"(lo2), "v"(hi2)); }
#endif
                            o[c] = MFMA32(vf, pf, o[c]);
#if defined(PROBE_PV2)
                            if (!SAMPLE && MODE == 0 && (wid & PROBE_PV2) == 0) { asm volatile("" : "+v"(o[c])); o[c] = MFMA32(vf, pf, o[c]); }
#endif
                        }
                    }
                }
            }
        }
        if (SAMPLE && p < p_hi) ATT_FINISH(p + 1, slot1);
        slot = slot1;
    }
    lsum += __shfl_xor(lsum, 32);
#if defined(PROBE_PV2)
    const float il = has ? ((!SAMPLE && MODE == 0 && (wid & PROBE_PV2) == 0) ? 0.5f : 1.f) / lsum : 0.f;
#else
    const float il = has ? 1.f / lsum : 0.f;
#endif
    if (MODE == 1) {
        if (has) {
            bf16* op = C.OB + (size_t)(qrow0 + r) * 1024 + hh * 128 + 4 * h;
#pragma unroll
            for (int c = 0; c < 4; ++c)
#pragma unroll
                for (int g = 0; g < 4; ++g) {
                    v2u w; w.x = pk2(o[c][4 * g] * il, o[c][4 * g + 1] * il); w.y = pk2(o[c][4 * g + 2] * il, o[c][4 * g + 3] * il);
                    *(GAS v2u*)(op + 32 * c + 8 * g) = w;
                }
        }
        __syncthreads();
    } else {
        const int sub = wid >> 1;
        LAS float* xch = (LAS float*)(lds + L_XCH) + sub * 4096;
        __syncthreads();
        if (has && t == 1) {
#pragma unroll
            for (int c = 0; c < 4; ++c)
#pragma unroll
                for (int i = 0; i < 16; ++i) xch[(32 * c + 8 * (i >> 2) + 4 * h + (i & 3)) * 32 + r] = o[c][i] * il;
        }
        __syncthreads();
        if (has && t == 0) {
            float ss = 0.f;
#pragma unroll
            for (int c = 0; c < 4; ++c)
#pragma unroll
                for (int i = 0; i < 16; ++i) { const float v = o[c][i] * il - C.lam * xch[(32 * c + 8 * (i >> 2) + 4 * h + (i & 3)) * 32 + r]; o[c][i] = v; ss += v * v; }
            ss += __shfl_xor(ss, 32);
            const float rs = C.osc / sqrtf(ss * (1.f / 128.f) + LN_EPS);
            bf16* op = C.OA + (size_t)(qrow0 + r) * 1024 + hh * 128 + 4 * h;
#pragma unroll
            for (int c = 0; c < 4; ++c)
#pragma unroll
                for (int g = 0; g < 4; ++g) {
                    const f32x4 gn = *(const GAS f32x4*)(C.subln + 32 * c + 8 * g + 4 * h);
                    v2u w; w.x = pk2(o[c][4 * g] * rs * gn[0], o[c][4 * g + 1] * rs * gn[1]); w.y = pk2(o[c][4 * g + 2] * rs * gn[2], o[c][4 * g + 3] * rs * gn[3]);
                    *(GAS v2u*)(op + 32 * c + 8 * g) = w;
                }
        }
        __syncthreads();
    }
}


#undef MFMA32
#undef ATT_ISSUE
#undef ATT_FINISH
}

#define XB_TMO      128
#define XB_XCNT(j)  (256  + 64 * (j))
#define XB_XSUB(j)  (1280 + 64 * (j))
#define XB_XGEN(j)  (2304 + 64 * (j))
#define XB_TOP      3328
#define XB_TOPGEN   3392
#define XCD_BAR_WORDS 3456
#define XB_SPIN_CAP (1u << 22)

__device__ __forceinline__ unsigned xb_ld(unsigned* p)              { return __hip_atomic_load(p, __ATOMIC_RELAXED, __HIP_MEMORY_SCOPE_AGENT); }
__device__ __forceinline__ unsigned xb_add(unsigned* p, unsigned v) { return __hip_atomic_fetch_add(p, v, __ATOMIC_RELAXED, __HIP_MEMORY_SCOPE_AGENT); }
__device__ __forceinline__ unsigned xb_xcc_id() { return (unsigned)__builtin_amdgcn_s_getreg((3 << 11) | 20) & 0xFu; }
#define XB_SPIN(cond, bar) do { unsigned _sp = 0; while (cond) { __builtin_amdgcn_s_sleep(1); \
    if ((++_sp & 255u) == 0u) { if (xb_ld(&(bar)[XB_TMO])) break; if (_sp > XB_SPIN_CAP) { atomicAdd(&(bar)[XB_TMO], 1u); break; } } } } while (0)

struct XcdBarrier {
    unsigned* bar; unsigned x;
    volatile LAS unsigned* st;
};

__device__ __forceinline__ XcdBarrier xcd_barrier_post(unsigned* bar, volatile LAS unsigned* st) {
    XcdBarrier b; b.bar = bar; b.x = xb_xcc_id(); b.st = st;
    if (threadIdx.x == 0) (void)xb_add(&bar[XB_XCNT(b.x)], 1u);
    return b;
}
__device__ __forceinline__ void xcd_barrier_complete(unsigned* bar, unsigned x, unsigned& nloc, unsigned& nx) {
    const unsigned G = gridDim.x * gridDim.y * gridDim.z;
    unsigned sum, cnt, mine, sp = 0u;
    for (;;) {
        sum = 0u; cnt = 0u; mine = 0u;
#pragma unroll
        for (unsigned j = 0; j < 16; ++j) { const unsigned c = xb_ld(&bar[XB_XCNT(j)]); sum += c; cnt += (c > 0u) ? 1u : 0u; mine = (j == x) ? c : mine; }
        if (sum == G) break;
        __builtin_amdgcn_s_sleep(1);
        if ((++sp & 255u) == 0u) { if (xb_ld(&bar[XB_TMO])) break; if (sp > XB_SPIN_CAP) { atomicAdd(&bar[XB_TMO], 1u); break; } }
    }
    nloc = mine > 0u ? mine : 1u; nx = cnt > 0u ? cnt : 1u;
}

__device__ __forceinline__ void xcd_barrier(const XcdBarrier& b) {
    asm volatile("s_waitcnt vmcnt(0)" ::: "memory");
    __syncthreads();
    if (threadIdx.x == 0) {
        unsigned* bar = b.bar; unsigned bx = b.x; asm volatile("" : "+s"(bar), "+s"(bx));
        __builtin_amdgcn_s_waitcnt(0);
        unsigned nloc = b.st[0], nx = b.st[1];
        if (nloc == 0u) { xcd_barrier_complete(bar, bx, nloc, nx); b.st[0] = nloc; b.st[1] = nx; }
        const unsigned old = xb_add(&bar[XB_XSUB(bx)], 1u);
        const unsigned gen = old / nloc;
        if (old + 1u == (gen + 1u) * nloc) {
            __builtin_amdgcn_fence(__ATOMIC_RELEASE, "agent");
            asm volatile("s_waitcnt vmcnt(0)" ::: "memory");
            const unsigned og = xb_add(&bar[XB_TOP], 1u);
            const unsigned tg = og / nx;
            if (og + 1u == (tg + 1u) * nx) xb_add(&bar[XB_TOPGEN], 1u);
            else XB_SPIN(xb_ld(&bar[XB_TOPGEN]) == tg, bar);
            __builtin_amdgcn_fence(__ATOMIC_ACQUIRE, "agent");
            xb_add(&bar[XB_XGEN(bx)], 1u);
            asm volatile("s_waitcnt vmcnt(0)" ::: "memory");
        } else {
            XB_SPIN(xb_ld(&bar[XB_XGEN(bx)]) == gen, bar);
            __builtin_amdgcn_fence(__ATOMIC_ACQUIRE, "agent");
            asm volatile("s_waitcnt vmcnt(0)" ::: "memory");
        }
    }
    __syncthreads();
}

#ifndef TAIL_S
#define TAIL_S 8
#endif
constexpr size_t WS_STAT = WS_MISC + 4096;
constexpr size_t WS_PRE = WS_QKVG + 512 * MiB;
constexpr size_t WS_SLAB = WS_QKVG + 448 * MiB;

struct Frame {
    LAS unsigned char* lds;
    volatile LAS unsigned* MISC;
    int tid, lane, wave, vcu, G;
};
struct Args { const float* in[N_IN]; float* out; unsigned char* ws; int ph_lo, ph_hi; };
__device__ __forceinline__ float wave_sum(float v) {
    v += __builtin_bit_cast(float, __builtin_amdgcn_update_dpp(0, __builtin_bit_cast(int, v), 0xB1, 0xF, 0xF, false));
    v += __builtin_bit_cast(float, __builtin_amdgcn_update_dpp(0, __builtin_bit_cast(int, v), 0x4E, 0xF, 0xF, false));
    v += __builtin_bit_cast(float, __builtin_amdgcn_update_dpp(0, __builtin_bit_cast(int, v), 0x141, 0xF, 0xF, false));
    v += __builtin_bit_cast(float, __builtin_amdgcn_update_dpp(0, __builtin_bit_cast(int, v), 0x140, 0xF, 0xF, false));
    const float s0 = __builtin_bit_cast(float, __builtin_amdgcn_readlane(__builtin_bit_cast(int, v), 0)), s1 = __builtin_bit_cast(float, __builtin_amdgcn_readlane(__builtin_bit_cast(int, v), 16));
    const float s2 = __builtin_bit_cast(float, __builtin_amdgcn_readlane(__builtin_bit_cast(int, v), 32)), s3 = __builtin_bit_cast(float, __builtin_amdgcn_readlane(__builtin_bit_cast(int, v), 48));
    return (s0 + s1) + (s2 + s3);
}
__device__ __forceinline__ unsigned char* opq(unsigned char* p) { asm volatile("" : "+s"(p)); return p; }
__device__ __forceinline__ bf16* wcopy(unsigned char* ws, int l, size_t off) { return (bf16*)(opq(ws) + WS_W + (size_t)l * WS_WL + off); }
__device__ __forceinline__ float* modp(unsigned char* ws, int l) { return (float*)(opq(ws) + WS_MOD) + (size_t)l * NSEQ * MODW; }

__device__ __forceinline__ void transpose_item(const float* W, int N, bf16* WT, int K, int k0, int n0, int dst_row0, LAS float* scr, int lane) {
    { f32x4 wv[8]; const int n4 = (lane & 7) * 4;
#pragma unroll
      for (int i = 0; i < 8; ++i) wv[i] = *(const GAS f32x4*)(W + (size_t)(k0 + 8 * i + (lane >> 3)) * N + n0 + n4);
#pragma unroll
      for (int i = 0; i < 8; ++i) { LAS float* d = scr + (8 * i + (lane >> 3)) * 33 + n4; d[0] = wv[i][0]; d[1] = wv[i][1]; d[2] = wv[i][2]; d[3] = wv[i][3]; } }
    LDS_WAIT(); asm volatile("" ::: "memory");
    const int c = lane & 7;
#pragma unroll
    for (int j = 0; j < 4; ++j) { const int n = (lane >> 3) + 8 * j; const LAS float* s = scr + (8 * c) * 33 + n;
        v4u o; o.x = pk2(s[0 * 33], s[1 * 33]); o.y = pk2(s[2 * 33], s[3 * 33]); o.z = pk2(s[4 * 33], s[5 * 33]); o.w = pk2(s[6 * 33], s[7 * 33]);
        *(GAS v4u*)(WT + (size_t)(dst_row0 + n) * K + k0 + 8 * c) = o; }
    LDS_WAIT(); asm volatile("" ::: "memory");
}
__device__ __forceinline__ void p0_weights(Frame& F, const Args& A) {
    LAS float* scr = (LAS float*)(F.lds + RING_OFF + F.wave * 16384);
    const int gw = F.vcu * NWAVES + F.wave, NGW = F.G * NWAVES;
    constexpr int I_IN = 32 * 320, I_OA = 16 * 64, I_OUT = 32 * 64, I_1 = 32 * 176, I_2 = 88 * 64, I_LAYER = I_IN + 2 * I_OA + I_OUT + 2 * I_1 + I_2;
    for (int it = gw; it < DEPTH * I_LAYER; it += NGW) {
        const int l = it / I_LAYER; int r = it % I_LAYER;
        if (r < I_IN) { transpose_item(A.in[I_WIN] + (size_t)l * D * INW, INW, wcopy(A.ws, l, WO_WIN), D, 64 * (r / 320), 32 * (r % 320), 32 * (r % 320), scr, F.lane); continue; } r -= I_IN;
        if (r < I_OA) { transpose_item(A.in[I_WOA] + (size_t)l * 1024 * D, D, wcopy(A.ws, l, WO_WOA), 1024, 64 * (r / 64), 32 * (r % 64), 32 * (r % 64), scr, F.lane); continue; } r -= I_OA;
        if (r < I_OA) { transpose_item(A.in[I_WOB] + (size_t)l * 1024 * D, D, wcopy(A.ws, l, WO_WOB), 1024, 64 * (r / 64), 32 * (r % 64), 32 * (r % 64), scr, F.lane); continue; } r -= I_OA;
        if (r < I_OUT) { transpose_item(A.in[I_WOUT] + (size_t)l * D * D, D, wcopy(A.ws, l, WO_WOUT), D, 64 * (r / 64), 32 * (r % 64), 32 * (r % 64), scr, F.lane); continue; } r -= I_OUT;
        if (r < I_1) { const int n0 = 32 * (r % 176); transpose_item(A.in[I_W1] + (size_t)l * D * FF, FF, wcopy(A.ws, l, WO_W13), D, 64 * (r / 176), n0, 256 * (n0 / 128) + (n0 % 128), scr, F.lane); continue; } r -= I_1;
        if (r < I_1) { const int n0 = 32 * (r % 176); transpose_item(A.in[I_W3] + (size_t)l * D * FF, FF, wcopy(A.ws, l, WO_W13), D, 64 * (r / 176), n0, 256 * (n0 / 128) + 128 + (n0 % 128), scr, F.lane); continue; } r -= I_1;
        transpose_item(A.in[I_W2] + (size_t)l * FF * D, D, wcopy(A.ws, l, WO_W2), FF, 64 * (r / 64), 32 * (r % 64), 32 * (r % 64), scr, F.lane);
    }
}
__device__ __forceinline__ void p0_mod(Frame& F, const Args& A) {
    LAS float* SC = (LAS float*)(F.lds + RING_OFF);
    const int r = F.lane & 31, h = F.lane >> 5;
    for (int it = blockIdx.x; it < DEPTH * (MODW / 32); it += gridDim.x) {
        const int l = it / (MODW / 32), n0 = (it % (MODW / 32)) * 32;
        const GAS float* W = (const GAS float*)(A.in[I_WMOD] + (size_t)l * D * MODW + n0 + r);
        f32x16 acc0, acc1;
#pragma unroll
        for (int i = 0; i < 16; ++i) { acc0[i] = 0.f; acc1[i] = 0.f; }
        for (int kq = 0; kq < 4; ++kq) {
            __syncthreads();
            { const int k = kq * 512 + F.tid;
#pragma unroll
              for (int s = 0; s < NSEQ; ++s) { const float c = ((const GAS float*)(s < NBP ? A.in[I_CP] + (size_t)s * D : A.in[I_CS] + (size_t)(s - NBP) * D))[k]; SC[F.tid * NSEQ + s] = c / (1.f + __expf(-c)); } }
            __syncthreads();
#pragma unroll 8
            for (int i = 0; i < 32; ++i) {
                const int kl = F.wave * 64 + 2 * i + h;
                const float a = W[(size_t)(kq * 512 + kl) * MODW];
                const float b0 = SC[kl * NSEQ + r], b1 = r < NSEQ - 32 ? SC[kl * NSEQ + 32 + r] : 0.f;
                acc0 = __builtin_amdgcn_mfma_f32_32x32x2f32(a, b0, acc0, 0, 0, 0);
                acc1 = __builtin_amdgcn_mfma_f32_32x32x2f32(a, b1, acc1, 0, 0, 0);
            }
        }
        __syncthreads();
        LAS float* RED = SC;
#pragma unroll
        for (int i = 0; i < 16; ++i) { const int n = (i & 3) + 8 * (i >> 2) + 4 * h;
            RED[(F.wave * 32 + n) * NSEQ + r] = acc0[i];
            if (r < NSEQ - 32) RED[(F.wave * 32 + n) * NSEQ + 32 + r] = acc1[i]; }
        __syncthreads();
        for (int o = F.tid; o < NSEQ * 32; o += NTHREADS) { const int s = o >> 5, c2 = o & 31; float v = 0.f;
#pragma unroll
            for (int w = 0; w < NWAVES; ++w) v += RED[(w * 32 + c2) * NSEQ + s];
            modp(A.ws, l)[(size_t)s * MODW + n0 + c2] = v + A.in[I_BMOD][(size_t)l * MODW + n0 + c2]; }
    }
    __syncthreads();
    if (blockIdx.x == 0 && F.wave < DEPTH) {
        const int l = F.wave, i = F.lane;
        const float s1 = wave_sum(A.in[I_LQ1][l * 64 + i] * A.in[I_LK1][l * 64 + i]), s2 = wave_sum(A.in[I_LQ2][l * 64 + i] * A.in[I_LK2][l * 64 + i]);
        const float lam_init = 0.8f - 0.6f * expf(-0.3f * (float)l);
        if (i == 0) ((float*)(opq(A.ws) + WS_MISC))[l] = expf(s1) - expf(s2) + lam_init;
    }
}
__device__ __forceinline__ void ln_stats(const f32x4 (&v)[8], float& mean, float& rstd) {
    float s = 0.f;
#pragma unroll
    for (int j = 0; j < 8; ++j) s += (v[j][0] + v[j][1]) + (v[j][2] + v[j][3]);
    mean = wave_sum(s) * (1.f / D); float q = 0.f;
#pragma unroll
    for (int j = 0; j < 8; ++j) { const f32x4 d = v[j] - mean; q += (d[0] * d[0] + d[1] * d[1]) + (d[2] * d[2] + d[3] * d[3]); }
    rstd = 1.f / sqrtf(wave_sum(q) * (1.f / D) + LN_EPS);
}
template <int KIND>
__device__ __forceinline__ void ln_row(f32x4 (&v)[8], const int row, const int lane, float* inout, const float* gain, const float* bias, const float* mrow, bf16* H, float* stats = nullptr) {
    f32x4 shv[8], scv[8];
    if (mrow) { const float* mr = mrow + (size_t)row_seq(row) * MODW;
#pragma unroll
        for (int j = 0; j < 8; ++j) { shv[j] = *(const GAS f32x4*)(mr + 4 * lane + 256 * j); scv[j] = *(const GAS f32x4*)(mr + D + 4 * lane + 256 * j); } }
    float mean, rstd;
    ln_stats(v, mean, rstd);
    if (KIND == 1) {
        float* dst = inout + (size_t)row * D;
        const bool keep = !(stats && row < MP);
        if (!keep && lane == 0) *(GAS f32x2v*)(stats + 2 * (size_t)row) = (f32x2v){mean, rstd};
#pragma unroll
        for (int j = 0; j < 8; ++j) { const f32x4 g = *(const GAS f32x4*)(gain + 4 * lane + 256 * j), bb = *(const GAS f32x4*)(bias + 4 * lane + 256 * j);
            v[j] = (v[j] - mean) * rstd * g + bb; if (keep) *(GAS f32x4*)(dst + 4 * lane + 256 * j) = v[j]; }
        if (mrow) ln_stats(v, mean, rstd);
    }
    if (mrow) {
        bf16* hp = H + (size_t)row * D;
#pragma unroll
        for (int j = 0; j < 8; ++j) { const f32x4 o = (v[j] - mean) * rstd * (scv[j] + 1.f) + shv[j];
            v2u w; w.x = pk2(o[0], o[1]); w.y = pk2(o[2], o[3]); *(GAS v2u*)(hp + 4 * lane + 256 * j) = w; }
    }
}
template <int KIND>
__device__ __forceinline__ void ln_phase(Frame& F, const float* xp, const float* xs, float* inout, const float* gain, const float* bias, const float* mrow, bf16* H,
                                         const bf16* pre = nullptr, const float* slab = nullptr, const int nparts = 0, float* stats = nullptr) {
    const int gw = F.vcu * NWAVES + F.wave, NGW = F.G * NWAVES;
    int lane_ = F.lane; asm volatile("" : "+v"(lane_)); const int lane = lane_;
    if (KIND == 0) {
        f32x4 vn[8];
        { const int row = gw; if (row < M) { const float* src = row < MP ? xp + (size_t)row * D : xs + (size_t)(row - MP) * D;
#pragma unroll
            for (int j = 0; j < 8; ++j) vn[j] = *(const GAS f32x4*)(src + 4 * lane + 256 * j); } }
        for (int row = gw; row < M; row += NGW) {
            f32x4 v[8];
#pragma unroll
            for (int j = 0; j < 8; ++j) v[j] = vn[j];
            { const int nrow = row + NGW; if (nrow < M) { const float* src = nrow < MP ? xp + (size_t)nrow * D : xs + (size_t)(nrow - MP) * D;
#pragma unroll
                for (int j = 0; j < 8; ++j) vn[j] = *(const GAS f32x4*)(src + 4 * lane + 256 * j); } }
            ln_row<KIND>(v, row, lane, inout, gain, bias, mrow, H);
        }
    } else {
        v2u vn[8];
        { const int row = gw; if (row < MP) { const bf16* src = pre + (size_t)row * D;
#pragma unroll
            for (int j = 0; j < 8; ++j) vn[j] = *(const GAS v2u*)(src + 4 * lane + 256 * j); } }
        for (int row = gw; row < MP; row += NGW) {
            f32x4 v[8];
#pragma unroll
            for (int j = 0; j < 8; ++j) v[j] = (f32x4){bflo(vn[j].x), bfhi(vn[j].x), bflo(vn[j].y), bfhi(vn[j].y)};
            { const int nrow = row + NGW; if (nrow < MP) { const bf16* src = pre + (size_t)nrow * D;
#pragma unroll
                for (int j = 0; j < 8; ++j) vn[j] = *(const GAS v2u*)(src + 4 * lane + 256 * j); } }
            ln_row<KIND>(v, row, lane, inout, gain, bias, mrow, H, stats);
        }
        for (int row = MP + gw; row < M; row += NGW) {
            f32x4 v[8];
            const float* s0 = slab + (size_t)(row - MP) * D + 4 * lane;
#pragma unroll
            for (int j = 0; j < 8; ++j) v[j] = (f32x4){0.f, 0.f, 0.f, 0.f};
            int p = 0;
#pragma unroll 1
            for (; p + 4 <= nparts; p += 4) {
                f32x4 t[4][8];
#pragma unroll
                for (int q = 0; q < 4; ++q)
#pragma unroll
                    for (int j = 0; j < 8; ++j) t[q][j] = *(const GAS f32x4*)(s0 + (size_t)(p + q) * MS * D + 256 * j);
#pragma unroll
                for (int j = 0; j < 8; ++j) v[j] = v[j] + ((t[0][j] + t[1][j]) + (t[2][j] + t[3][j]));
            }
#pragma unroll 1
            for (; p < nparts; ++p) {
#pragma unroll
                for (int j = 0; j < 8; ++j) v[j] = v[j] + *(const GAS f32x4*)(s0 + (size_t)p * MS * D + 256 * j);
            }
            ln_row<KIND>(v, row, lane, inout, gain, bias, mrow, H, stats);
        }
    }
}

__device__ __forceinline__ void kv_outputs(Frame& F, const bf16* QKVGp, float* out, int l) {
    const int gw = F.vcu * NWAVES + F.wave, NGW = F.G * NWAVES;
    int lane_ = F.lane; asm volatile("" : "+v"(lane_)); const int lane = lane_;
    v4u wn[8];
#define KV_LOAD(dst_, row_) do { const int r_ = (row_); const bool hb_ = r_ >= MP || (r_ & (SEQ - 1)) >= SEQ - 512; const bf16* s_ = QKVGp + (size_t)r_ * INW; \
        _Pragma("unroll") for (int j = 0; j < 8; ++j) if (j < 4 || hb_) dst_[j] = *(const GAS v4u*)(s_ + (j < 2 ? C_KA : j < 4 ? C_VA : j < 6 ? C_KB : C_VB) + (size_t)(8 * (lane + 64 * (j & 1)))); } while (0)
    if (gw < M) KV_LOAD(wn, gw);
    for (int row = gw; row < M; row += NGW) {
        const bool samp = row >= MP; const int t = row & (SEQ - 1);
        const bool hasb = samp || t >= SEQ - 512;
        float* oa = samp ? out + O_AKS + ((size_t)l * MS + (row - MP)) * 1024 : out + O_AKP + ((size_t)l * MP + row) * 1024;
        float* ob = samp ? out + O_BKS + ((size_t)l * MS + (row - MP)) * 1024 : out + O_BKP + ((size_t)(l * NBP + (row >> 12)) * 512 + (t - (SEQ - 512))) * 1024;
        const size_t av_off = samp ? O_AVS - O_AKS : O_AVP - O_AKP, bv_off = samp ? O_BVS - O_BKS : O_BVP - O_BKP;
        v4u w[8];
#pragma unroll
        for (int j = 0; j < 8; ++j) w[j] = wn[j];
        if (row + NGW < M) KV_LOAD(wn, row + NGW);
#pragma unroll
        for (int j = 0; j < 8; ++j) if (j < 4 || hasb) {
            float* dst = (j < 4 ? oa + (j >= 2 ? av_off : 0) : ob + (j >= 6 ? bv_off : 0)) + 8 * (lane + 64 * (j & 1));
            const f32x4 a = {bflo(w[j].x), bfhi(w[j].x), bflo(w[j].y), bfhi(w[j].y)}, b = {bflo(w[j].z), bfhi(w[j].z), bflo(w[j].w), bfhi(w[j].w)};
            __builtin_nontemporal_store(a, (GAS f32x4*)dst); __builtin_nontemporal_store(b, (GAS f32x4*)(dst + 4));
        }
    }
#undef KV_LOAD
}
__device__ __forceinline__ void attn_phase(Frame& F, const Args& A, int l) {
    kv_outputs(F, (const bf16*)(opq(A.ws) + WS_QKVG), (float*)opq((unsigned char*)A.out), l);
    att::build_tables(F.lds + RING_OFF, A.in[I_T5], A.in[I_REL] + (size_t)l * 257 * 8);
    att::Ctx C;
    C.QKVG = (const bf16*)(opq(A.ws) + WS_QKVG);
    C.cak = A.in[I_CAK] + (size_t)l * NBS * PAST * 1024; C.cav = A.in[I_CAV] + (size_t)l * NBS * PAST * 1024;
    C.cbk = A.in[I_CBK] + (size_t)l * NBS * BPAST * 1024; C.cbv = A.in[I_CBV] + (size_t)l * NBS * BPAST * 1024;
    C.OA = (bf16*)(opq(A.ws) + WS_OA); C.OB = (bf16*)(opq(A.ws) + WS_OB);
    C.subln = A.in[I_SUBLN] + l * 128;
    C.lam = ((const float*)(opq(A.ws) + WS_MISC))[l];
    C.osc = 1.f - (0.8f - 0.6f * expf(-0.3f * (float)l));
    LAS unsigned char* lds = F.lds + RING_OFF;
#ifndef PROBE_ATT
#define PROBE_ATT 0
#endif
#ifndef ATT_MASK
#define ATT_MASK 15
#endif
#define ATT_A_LOOP() if (ATT_MASK & 1) for (int pj = F.vcu; pj < 1024; pj += F.G) { const int pi = 1023 - pj, bh = pi >> 4, s = pi & 15;     \
        _Pragma("unroll 1") for (int k = 0; k < 2; ++k) att::unit<0, false>(lds, C, bh >> 3, bh & 7, k == 0 ? 31 - s : s); }
#define ATT_B_LOOP() if (ATT_MASK & 2) for (int bj = F.vcu; bj < 1024; bj += F.G) { const int bi = 1023 - bj, bh = bi >> 4; att::unit<1, false>(lds, C, bh >> 3, bh & 7, bi & 15); }
#define ATT_S_LOOP() do { if (ATT_MASK & 4) for (int si = F.vcu; si < NBS * 8; si += F.G) att::unit<0, true>(lds, C, si >> 3, si & 7, 0); \
        if (ATT_MASK & 8) for (int si = F.vcu; si < NBS * 8; si += F.G) att::unit<1, true>(lds, C, si >> 3, si & 7, 0); } while (0)
    ATT_A_LOOP();
#if PROBE_ATT & 1
    ATT_A_LOOP();
#endif
    ATT_B_LOOP();
#if PROBE_ATT & 2
    ATT_B_LOOP();
#endif
    ATT_S_LOOP();
#if PROBE_ATT & 4
    ATT_S_LOOP();
#endif
#undef ATT_A_LOOP
#undef ATT_B_LOOP
#undef ATT_S_LOOP
}

#ifndef MK_STAGGER
#define MK_STAGGER 0
#endif
#define STAG(t) (MK_STAGGER ? (t) : 0u)
#ifndef PROBE_REP
#define PROBE_REP 0
#endif
#ifndef MK_PER_PHASE
#define MK_PER_PHASE 0
#endif
constexpr int N_PHASES = 2 + 8 * DEPTH;
__global__ void __launch_bounds__(NTHREADS, 2) fwd_kernel(Args args) {
    extern __shared__ __attribute__((aligned(16))) unsigned char lds[];
    Frame F;
    F.lds = (LAS unsigned char*)lds;
    F.MISC = (volatile LAS unsigned*)(F.lds + MISC_OFF);
    F.tid = threadIdx.x; F.lane = F.tid & 63; F.wave = __builtin_amdgcn_readfirstlane(F.tid >> 6);
    F.G = gridDim.x; { const int bx = blockIdx.x; F.vcu = (F.G % 8 == 0) ? (bx % 8) * (F.G / 8) + bx / 8 : bx; }
    for (int u = F.tid; u < (LDS_BYTES - LDSCTL_OFF) / 4; u += NTHREADS) ((LAS unsigned*)(F.lds + LDSCTL_OFF))[u] = 0u;
    __syncthreads();
    XcdBarrier bar; bar.bar = (unsigned*)((gu32*)(opq(args.ws) + WS_CTL) + CW_BAR); bar.x = 0; bar.st = nullptr;
    if (!MK_PER_PHASE) bar = xcd_barrier_post((unsigned*)((gu32*)(opq(args.ws) + WS_CTL) + CW_BAR), F.MISC + 8);
    const int lo = args.ph_lo, hi = args.ph_hi; (void)lo; (void)hi;
#ifndef PH_MASK
#define PH_MASK 0xffffffffu
#endif
#define PHM(j) ((PH_MASK >> (j)) & 1u)
#if MK_PER_PHASE
#define IN(k) (lo <= (k) && (k) < hi)
#else
#define IN(k) true
#endif
#if defined(PROBE_BAR2)
#define SEAM(k) do { if (IN(k) && IN((k) + 1)) { xcd_barrier(bar); xcd_barrier(bar); } } while (0)
#else
#define SEAM(k) do { if (IN(k) && IN((k) + 1)) xcd_barrier(bar); } while (0)
#endif

#define Hb ((bf16*)(opq(args.ws) + WS_H))
#define QKVG ((bf16*)(opq(args.ws) + WS_QKVG))
#define XB ((float*)(opq(args.ws) + WS_XB))
#define Y ((float*)opq((unsigned char*)args.out) + O_YP)
    LAS unsigned char* const ring = F.lds + RING_OFF;
    const int tailS = F.G >= 32 * TAIL_S ? TAIL_S : F.G >= 128 ? 4 : F.G >= 64 ? 2 : 1;

    for (int rep_ = 0; rep_ < (PROBE_REP == 100 ? 2 : 1); ++rep_) { if (PHM(0) && IN(0)) { p0_weights(F, args); __syncthreads(); }
    if (PHM(10) && IN(0)) { p0_mod(F, args); } __syncthreads();
#if PROBE_REP == 102
    p0_mod(F, args); __syncthreads();
#endif
#if PROBE_REP == 103
    p0_weights(F, args); __syncthreads();
#endif
    }
    SEAM(0);
    if (PHM(1) && IN(1)) ln_phase<0>(F, args.in[I_XP], args.in[I_XS], nullptr, nullptr, nullptr, modp(args.ws, 0), Hb);
#if PROBE_REP == 101
    __syncthreads(); ln_phase<0>(F, args.in[I_XP], args.in[I_XS], nullptr, nullptr, nullptr, modp(args.ws, 0), Hb);
    __syncthreads(); ln_phase<0>(F, args.in[I_XP], args.in[I_XS], nullptr, nullptr, nullptr, modp(args.ws, 0), Hb);
#endif
    SEAM(1);
#pragma unroll 1
    for (int l = 0; l < DEPTH; ++l) {
        const int pb = 2 + 8 * l;
        const float* xin_p = l == 0 ? args.in[I_XP] : Y;
        const float* xin_s = l == 0 ? args.in[I_XS] : Y + (size_t)MP * D;
        for (int rep_ = 0; rep_ < (PROBE_REP == 2 ? 2 : 1); ++rep_) if (PHM(2) && IN(pb + 0)) {
            pg8::Gemm g{Hb, wcopy(args.ws, l, WO_WIN), M, INW, D}; pg8::StaticOrder S; S.init(M, INW, F.G, (int)blockIdx.x, D);
            pg8::EpiIn E{QKVG, (float*)opq((unsigned char*)args.out), l};
            pg8::gemm_phase<pg8::EpiIn, pg8::StaticOrder, true, true>(ring, g, S, E, STAG(6000u));
        }
        SEAM(pb + 0);
        if (PHM(3) && IN(pb + 1)) { attn_phase(F, args, l);
#if defined(PROBE_ATTN2)
            __syncthreads(); attn_phase(F, args, l);
#endif
        }
        SEAM(pb + 1);
        for (int rep_ = 0; rep_ < (PROBE_REP == 4 ? 2 : 1); ++rep_) if (PHM(4) && IN(pb + 2)) {
            { pg8::Gemm g{(const bf16*)(opq(args.ws) + WS_OA), wcopy(args.ws, l, WO_WOA), M, D, 1024}; pg8::StaticOrder S; S.init(M, D, F.G, (int)blockIdx.x, 1024);
              pg8::EpiGate<false> E{Hb, QKVG, C_GA};
              pg8::gemm_phase<pg8::EpiGate<false>, pg8::StaticOrder, true, true>(ring, g, S, E, STAG(3400u));
              { const int nwg_ = (M / 256) * (D / 256), whole_ = nwg_ / F.G, T_ = nwg_ - whole_ * F.G;
                if (T_ > 0 && 2 * T_ <= F.G && (int)blockIdx.x < T_ && F.tid == 0) {
                    __builtin_amdgcn_fence(__ATOMIC_RELEASE, "agent"); asm volatile("s_waitcnt vmcnt(0)" ::: "memory");
                    __hip_atomic_store((gu32*)(opq(args.ws) + WS_CTL) + 64 + 64 * l + (int)blockIdx.x, 1u, RLX_AGENT); } } }
            { pg8::Gemm g{(const bf16*)(opq(args.ws) + WS_OB), wcopy(args.ws, l, WO_WOB), M, D, 1024}; pg8::ShiftedTailOrder S; S.init(M, D, F.G, (int)blockIdx.x, 1024, (unsigned*)((gu32*)(opq(args.ws) + WS_CTL) + 64 + 64 * l));
              pg8::EpiGate<true> E{Hb, QKVG, C_GB};
              pg8::gemm_phase<pg8::EpiGate<true>, pg8::ShiftedTailOrder, true, true>(ring, g, S, E, STAG(3400u)); }
        }
        SEAM(pb + 2);
        for (int rep_ = 0; rep_ < (PROBE_REP == 5 ? 2 : 1); ++rep_) if (PHM(5) && IN(pb + 3)) {
            pg8::Gemm g{Hb, wcopy(args.ws, l, WO_WOUT), M, D, D}; pg8::TailOrder S; S.init(D, F.G, (int)blockIdx.x, D, tailS);
            pg8::EpiRes E{xin_p, xin_s, modp(args.ws, l) + 2 * D, (bf16*)(opq(args.ws) + WS_PRE), (float*)(opq(args.ws) + WS_SLAB), nullptr, nullptr, nullptr};
            pg8::gemm_phase<pg8::EpiRes, pg8::TailOrder, true, true>(ring, g, S, E, STAG(6000u));
        }
        SEAM(pb + 3);
        if (PHM(6) && IN(pb + 4)) ln_phase<1>(F, nullptr, nullptr, XB, args.in[I_LN1G] + l * D, args.in[I_LN1B] + l * D, modp(args.ws, l) + 3 * D, Hb, (const bf16*)(opq(args.ws) + WS_PRE), (const float*)(opq(args.ws) + WS_SLAB), tailS, (float*)(opq(args.ws) + WS_STAT));
        SEAM(pb + 4);
        for (int rep_ = 0; rep_ < (PROBE_REP == 7 ? 2 : 1); ++rep_) if (PHM(7) && IN(pb + 5)) {
            pg8::Gemm g{Hb, wcopy(args.ws, l, WO_W13), M, FF2, D}; pg8::StaticOrder S; S.init(M, FF2, F.G, (int)blockIdx.x, D);
            pg8::EpiSwiGLU E{QKVG};
            pg8::gemm_phase<pg8::EpiSwiGLU, pg8::StaticOrder, true, true>(ring, g, S, E, STAG(5000u));
        }
        SEAM(pb + 5);
        for (int rep_ = 0; rep_ < (PROBE_REP == 8 ? 2 : 1); ++rep_) if (PHM(8) && IN(pb + 6)) {
            pg8::Gemm g{QKVG, wcopy(args.ws, l, WO_W2), M, D, FF}; pg8::TailOrder S; S.init(D, F.G, (int)blockIdx.x, FF, tailS, true);
            pg8::EpiRes E{XB, XB + (size_t)MP * D, modp(args.ws, l) + 5 * D, (bf16*)(opq(args.ws) + WS_PRE), (float*)(opq(args.ws) + WS_SLAB), (const float*)(opq(args.ws) + WS_STAT), args.in[I_LN1G] + l * D, args.in[I_LN1B] + l * D};
            pg8::gemm_phase<pg8::EpiRes, pg8::TailOrder, true, true>(ring, g, S, E, STAG(15000u));
        }
        SEAM(pb + 6);
        if (PHM(9) && IN(pb + 7)) ln_phase<1>(F, nullptr, nullptr, Y, args.in[I_LN2G] + l * D, args.in[I_LN2B] + l * D, l + 1 < DEPTH ? modp(args.ws, l + 1) : nullptr, Hb, (const bf16*)(opq(args.ws) + WS_PRE), (const float*)(opq(args.ws) + WS_SLAB), tailS);
        if (l + 1 < DEPTH) SEAM(pb + 7);
    }
#undef IN
#undef SEAM
#undef Hb
#undef QKVG
#undef XB
#undef Y
}

extern "C" void kernel_launch(void* const* d_in, const int* in_sizes, int n_in, void* d_out, int out_size, void* d_ws, size_t ws_size, hipStream_t stream) {
    static int grid = 0;
    if (grid == 0) {
        if (n_in != N_IN || in_sizes[0] != MP * D || (size_t)out_size != O_TOTAL || ws_size < WS_END) {
            fprintf(stderr, "kernel_launch: unexpected problem: n_in %d in0 %d out %d ws %zu (need %zu); nothing launched\n", n_in, n_in > 0 ? in_sizes[0] : -1, out_size, ws_size, (size_t)WS_END); grid = -1; return; }
        int dev = 0, cus = 0, per_cu = 0;
        if (hipGetDevice(&dev) != hipSuccess || hipDeviceGetAttribute(&cus, hipDeviceAttributeMultiprocessorCount, dev) != hipSuccess) { grid = -1; return; }
        if (hipFuncSetAttribute((const void*)fwd_kernel, hipFuncAttributeMaxDynamicSharedMemorySize, LDS_BYTES) != hipSuccess) { fprintf(stderr, "kernel_launch: hipFuncSetAttribute failed\n"); grid = -1; return; }
        if (hipOccupancyMaxActiveBlocksPerMultiprocessor(&per_cu, (const void*)fwd_kernel, NTHREADS, LDS_BYTES) != hipSuccess || per_cu < 1)
            fprintf(stderr, "kernel_launch: note: occupancy query reports %d workgroups per CU\n", per_cu);
        (void)hipGetLastError();
        grid = cus;
    }
    if (grid < 0) return;
    if (hipMemsetAsync((char*)d_ws + WS_CTL, 0, CTL_ZERO_BYTES, stream) != hipSuccess) return;
    Args a{};
    for (int i = 0; i < N_IN; ++i) a.in[i] = (const float*)d_in[i];
    a.out = (float*)d_out; a.ws = (unsigned char*)d_ws;
#if MK_PER_PHASE
    for (int p = 0; p < N_PHASES; ++p) { a.ph_lo = p; a.ph_hi = p + 1; hipLaunchKernelGGL(fwd_kernel, dim3(grid), dim3(NTHREADS), LDS_BYTES, stream, a); }
#else
    a.ph_lo = 0; a.ph_hi = N_PHASES;
    hipLaunchKernelGGL(fwd_kernel, dim3(grid), dim3(NTHREADS), LDS_BYTES, stream, a);
#endif
    const hipError_t le = hipPeekAtLastError();
    if (le != hipSuccess) fprintf(stderr, "kernel_launch: launch failed: %s\n", hipGetErrorName(le));
}
```
